# Optimizing an MI355X kernel written in HIP

```python
import math, functools
import jax, jax.numpy as jnp
from jax import lax
import numpy as np

D_MODEL = 1024
BATCH = 16
SEQ = 256
DEPTH = 4
DEC_BATCH = 4
DEC_SEQ = 2048
PAST_LEN = 256

GRID_W = 64
MIX_HALF = D_MODEL // 2
H_RET = 4
DV_RET = MIX_HALF // H_RET
DK_RET = DV_RET // 2
RET_CHUNK = 128
H_DIFF = 4
DV_DIFF = MIX_HALF // H_DIFF
DH_DIFF = DV_DIFF // 2
Q_BLOCK = 128
H_SWA = 8
KV_SWA = 2
SWA_GROUP = H_SWA // KV_SWA
DH_SWA = MIX_HALF // H_SWA
WINDOW = 128
SWA_BLOCK = 128
H_GLA = 4
DV_GLA = MIX_HALF // H_GLA
DK_GLA = DV_GLA // 2
GLA_RANK = 16
GLA_TAU = 16.0
GLA_CHUNK = 16
D_FF = 4 * D_MODEL
ROPE_BASE = 10000.0
N_EVEN = (DEPTH + 1) // 2
N_ODD = DEPTH // 2
ALPHA = (2 * DEPTH) ** 0.25
BETA = (8 * DEPTH) ** -0.25
EVEN_SPLITS = (H_RET * DK_RET, H_RET * DK_RET, H_RET * DV_RET, H_RET * DV_RET,
               H_DIFF * 2 * DH_DIFF, H_DIFF * 2 * DH_DIFF, H_DIFF * DV_DIFF)
ODD_SPLITS = (H_SWA * DH_SWA, KV_SWA * DH_SWA, KV_SWA * DH_SWA, H_GLA * DK_GLA, H_GLA * DK_GLA,
              H_GLA * DV_GLA, H_GLA * DV_GLA, 2 * GLA_RANK)
EVEN_IN = sum(EVEN_SPLITS)
ODD_IN = sum(ODD_SPLITS)
EVEN_OUT = H_RET * DV_RET + H_DIFF * DV_DIFF
ODD_OUT = H_SWA * DH_SWA + H_GLA * DV_GLA

kernel_name = 'hybrid_diffusion_trunk_step'


def _split(t, sizes):
    return jnp.split(t, [int(i) for i in np.cumsum(sizes)[:-1]], axis=-1)


def _heads(t, n):
    B, T, _ = t.shape
    return t.reshape(B, T, n, -1).transpose(0, 2, 1, 3)


def _merge_heads(t):
    B, H, T, d = t.shape
    return t.transpose(0, 2, 1, 3).reshape(B, T, H * d)


def _diff_heads(t):
    B, T, _ = t.shape
    return t.reshape(B, T, H_DIFF, 2, DH_DIFF).transpose(0, 2, 3, 1, 4)


def _layer_norm(x, g, b, eps=1e-5):
    xf = x.astype(jnp.float32)
    mu = jnp.mean(xf, axis=-1, keepdims=True)
    var = jnp.mean(jnp.square(xf - mu), axis=-1, keepdims=True)
    y = (xf - mu) * lax.rsqrt(var + eps) * g.astype(jnp.float32) + b.astype(jnp.float32)
    return y.astype(x.dtype)


def _head_norm(t, eps=1e-5):
    tf = t.astype(jnp.float32)
    mu = jnp.mean(tf, axis=-1, keepdims=True)
    var = jnp.mean(jnp.square(tf - mu), axis=-1, keepdims=True)
    return (tf - mu) * lax.rsqrt(var + eps)


def _axial_rope(rows, dim):
    row = jnp.repeat(jnp.arange(rows), GRID_W).astype(jnp.float32)
    col = jnp.tile(jnp.arange(GRID_W), rows).astype(jnp.float32)
    half = dim // 2
    freqs = ROPE_BASE ** (-jnp.arange(0, half, 2, dtype=jnp.float32) / half)
    ar = row[:, None] * freqs
    ac = col[:, None] * freqs
    return (jnp.cos(ar), jnp.sin(ar), jnp.cos(ac), jnp.sin(ac))


def _rot_half(x, cos, sin):
    x1, x2 = jnp.split(x, 2, axis=-1)
    return jnp.concatenate([x1 * cos - x2 * sin, x2 * cos + x1 * sin], axis=-1)


def _apply_axial_rope(x, tabs):
    cr, sr, cc, sc = tabs
    xf = x.astype(jnp.float32)
    xr, xc = jnp.split(xf, 2, axis=-1)
    return jnp.concatenate([_rot_half(xr, cr, sr), _rot_half(xc, cc, sc)], axis=-1).astype(x.dtype)


def _sink_softmax(logits, sink):
    full = jnp.concatenate([logits, jnp.broadcast_to(sink, logits.shape[:-1] + (1,))], axis=-1)
    return jax.nn.softmax(full, axis=-1)[..., :-1]


def _retention_dir(q, k, v, log_gamma, s0):
    B, H, T, dk = q.shape
    dv = v.shape[-1]
    C = RET_CHUNK
    N = T // C
    qc = q.reshape(B, H, N, C, dk)
    kc = k.reshape(B, H, N, C, dk)
    vc = v.reshape(B, H, N, C, dv)
    pos = jnp.arange(C, dtype=jnp.float32)
    dist = pos[:, None] - pos[None, :]
    dmat = jnp.where(dist >= 0, jnp.exp(log_gamma[:, None, None] * jnp.maximum(dist, 0.0)), 0.0)
    scores = jnp.einsum('bhnid,bhnjd->bhnij', qc, kc) * dmat[None, :, None]
    o_intra = jnp.einsum('bhnij,bhnje->bhnie', scores, vc)
    k_w = jnp.exp(log_gamma[:, None] * (C - 1 - pos))
    u = jnp.einsum('bhnjd,hj,bhnje->bhnde', kc, k_w, vc)
    chunk_decay = jnp.exp(log_gamma * C)[None, :, None, None]

    def step(s, uu):
        return chunk_decay * s + uu, s

    s_fin, s_prev = lax.scan(step, s0, jnp.moveaxis(u, 2, 0))
    q_w = jnp.exp(log_gamma[:, None] * (pos + 1.0))
    o_inter = jnp.einsum('bhnid,hi,nbhde->bhnie', qc, q_w, s_prev)
    return (o_intra + o_inter).reshape(B, H, T, dv), s_fin


def _bidir_retention(q, k, v, log_g, s0f, s0b):
    f32 = jnp.float32
    q, k, v = q.astype(f32), k.astype(f32), v.astype(f32)
    o_f, s_f = _retention_dir(q, k, v, log_g[0], s0f.astype(f32))
    fl = lambda t: jnp.flip(t, axis=2)
    o_b, s_b = _retention_dir(fl(q), fl(k), fl(v), log_g[1], s0b.astype(f32))
    return o_f + fl(o_b), s_f, s_b


def _gla_dir(q, k, v, log_a, s0):
    B, H, T, dk = q.shape
    dv = v.shape[-1]
    C = GLA_CHUNK
    N = T // C
    qc = q.reshape(B, H, N, C, dk)
    kc = k.reshape(B, H, N, C, dk)
    vc = v.reshape(B, H, N, C, dv)
    b = jnp.cumsum(log_a.reshape(B, H, N, C, dk), axis=3)
    causal = jnp.tril(jnp.ones((C, C), dtype=bool))
    rel = jnp.where(causal[:, :, None], b[:, :, :, :, None, :] - b[:, :, :, None, :, :], -jnp.inf)
    attn = jnp.einsum('bhnid,bhnjd,bhnijd->bhnij', qc, kc, jnp.exp(rel))
    o_intra = jnp.einsum('bhnij,bhnje->bhnie', attn, vc)
    b_last = b[:, :, :, -1:, :]
    u = jnp.einsum('bhnjd,bhnje->bhnde', kc * jnp.exp(b_last - b), vc)
    decay = jnp.exp(b_last[:, :, :, 0, :])

    def step(s, xs):
        d, uu = xs
        return d[..., None] * s + uu, s

    s_fin, s_prev = lax.scan(step, s0, (jnp.moveaxis(decay, 2, 0), jnp.moveaxis(u, 2, 0)))
    o_inter = jnp.einsum('bhnid,nbhde->bhnie', qc * jnp.exp(b), s_prev)
    return (o_intra + o_inter).reshape(B, H, T, dv), s_fin


def _gla_log_gates(glr, w2, b2):
    B, T, _ = glr.shape
    z = jnp.einsum('btdr,drk->dbtk', glr.reshape(B, T, 2, GLA_RANK), w2) + b2[:, None, None, :]
    log_a = jax.nn.log_sigmoid(z.astype(jnp.float32)) / GLA_TAU
    return log_a.reshape(2, B, T, H_GLA, DK_GLA).transpose(0, 1, 3, 2, 4)


def _bidir_gla(q, k, v, log_a, s0f, s0b):
    f32 = jnp.float32
    q, k, v = q.astype(f32), k.astype(f32), v.astype(f32)
    o_f, s_f = _gla_dir(q, k, v, log_a[0], s0f.astype(f32))
    fl = lambda t: jnp.flip(t, axis=2)
    o_b, s_b = _gla_dir(fl(q), fl(k), fl(v), fl(log_a[1]), s0b.astype(f32))
    return o_f + fl(o_b), s_f, s_b


def _diff_lambda(p, lam_init):
    p = p.astype(jnp.float32)
    return jnp.exp(jnp.sum(p[0] * p[1])) - jnp.exp(jnp.sum(p[2] * p[3])) + lam_init


def _diff_core(q, k, v, lam):
    s = jnp.einsum('bhmqd,bhmkd->bhmqk', q, k).astype(jnp.float32) * DH_DIFF ** -0.5
    p = jax.nn.softmax(s, axis=-1)
    w = p[:, :, 0] - lam * p[:, :, 1]
    return jnp.einsum('bhqk,bhkd->bhqd', w.astype(v.dtype), v)


def _sink_attention_ctx(q, k, v, sink):
    B, KV, G, L, dh = q.shape
    s = jnp.einsum('bkgqd,bkld->bkgql', q, k).astype(jnp.float32) * dh ** -0.5
    p = _sink_softmax(s, sink.astype(jnp.float32).reshape(KV, G)[None, :, :, None, None])
    o = jnp.einsum('bkgql,bkld->bkgqd', p.astype(v.dtype), v)
    return o.reshape(B, KV * G, L, dh)


def _banded_sink_attention(q, k, v, k_ctx, v_ctx, sink):
    B, KV, G, T, dh = q.shape
    W = SWA_BLOCK
    NB = T // W
    L = k_ctx.shape[2]

    def band(t):
        tp = jnp.pad(t, ((0, 0), (0, 0), (W, W), (0, 0))).reshape(B, KV, NB + 2, W, dh)
        return jnp.concatenate([tp[:, :, :-2], tp[:, :, 1:-1], tp[:, :, 2:]], axis=3)

    kb, vb = band(k), band(v)
    qb = q.reshape(B, KV, G, NB, W, dh)
    scale = dh ** -0.5
    s_loc = jnp.einsum('bkgnqd,bknjd->bkgnqj', qb, kb).astype(jnp.float32) * scale
    s_ctx = jnp.einsum('bkgnqd,bkld->bkgnql', qb, k_ctx).astype(jnp.float32) * scale
    blk = jnp.arange(NB)[:, None, None]
    qpos = blk * W + jnp.arange(W)[None, :, None]
    kpos = (blk - 1) * W + jnp.arange(3 * W)[None, None, :]
    allowed = (kpos >= 0) & (kpos < T) & (jnp.abs(qpos - kpos) <= WINDOW)
    s_loc = jnp.where(allowed, s_loc, -jnp.inf)
    p = _sink_softmax(jnp.concatenate([s_ctx, s_loc], axis=-1),
                      sink.astype(jnp.float32).reshape(KV, G)[None, :, :, None, None, None])
    p = p.astype(v.dtype)
    o = (jnp.einsum('bkgnql,bkld->bkgnqd', p[..., :L], v_ctx)
         + jnp.einsum('bkgnqj,bknjd->bkgnqd', p[..., L:], vb))
    return o.reshape(B, KV * G, T, dh)


def _even_ctx(h, w_in, w_out, log_g, lam, lam_init):
    B, L, _ = h.shape
    rq, rk, rv, rg, dq, dk, dv = _split(h @ w_in, EVEN_SPLITS)
    zero = jnp.zeros((B, H_RET, DK_RET, DV_RET), jnp.float32)
    o_r, s_f, s_b = _bidir_retention(_heads(rq, H_RET), _heads(rk, H_RET) * DK_RET ** -0.5,
                                     _heads(rv, H_RET), log_g, zero, zero)
    ret = _merge_heads(_head_norm(o_r)).astype(h.dtype) * jax.nn.silu(rg)
    q2, k2, v2 = _diff_heads(dq), _diff_heads(dk), _heads(dv, H_DIFF)
    o_d = _diff_core(q2, k2, v2, lam)
    diff = _merge_heads(_head_norm(o_d)).astype(h.dtype) * (1.0 - lam_init)
    out = jnp.concatenate([ret, diff], axis=-1) @ w_out
    return out, (jnp.stack([s_f, s_b], axis=1), k2, v2)


def _even_latent(h, rope, w_in, w_out, log_g, lam, lam_init, st_ret, ck, cv):
    B, T, _ = h.shape
    rq, rk, rv, rg, dq, dk, dv = _split(h @ w_in, EVEN_SPLITS)
    o_r, _, _ = _bidir_retention(_heads(rq, H_RET), _heads(rk, H_RET) * DK_RET ** -0.5,
                                 _heads(rv, H_RET), log_g, st_ret[:, 0], st_ret[:, 1])
    ret = _merge_heads(_head_norm(o_r)).astype(h.dtype) * jax.nn.silu(rg)
    q2 = _apply_axial_rope(_diff_heads(dq), rope)
    k_all = jnp.concatenate([ck, _apply_axial_rope(_diff_heads(dk), rope)], axis=3)
    v_all = jnp.concatenate([cv, _heads(dv, H_DIFF)], axis=2)
    qb = jnp.moveaxis(q2.reshape(B, H_DIFF, 2, T // Q_BLOCK, Q_BLOCK, DH_DIFF), 3, 0)
    ob = lax.map(lambda qq: _diff_core(qq, k_all, v_all, lam), qb)
    o_d = jnp.moveaxis(ob, 0, 2).reshape(B, H_DIFF, T, DV_DIFF)
    diff = _merge_heads(_head_norm(o_d)).astype(h.dtype) * (1.0 - lam_init)
    return jnp.concatenate([ret, diff], axis=-1) @ w_out, ()


def _odd_ctx(h, w_in, w_out, sink, w2, b2):
    B, L, _ = h.shape
    sq, sk, sv, gq, gk, gv, gr, glr = _split(h @ w_in, ODD_SPLITS)
    q = _heads(sq, H_SWA).reshape(B, KV_SWA, SWA_GROUP, L, DH_SWA)
    k, v = _heads(sk, KV_SWA), _heads(sv, KV_SWA)
    swa = _merge_heads(_sink_attention_ctx(q, k, v, sink))
    zero = jnp.zeros((B, H_GLA, DK_GLA, DV_GLA), jnp.float32)
    o_g, s_f, s_b = _bidir_gla(_heads(gq, H_GLA) * DK_GLA ** -0.5, _heads(gk, H_GLA), _heads(gv, H_GLA),
                               _gla_log_gates(glr, w2, b2), zero, zero)
    gla = _merge_heads(_head_norm(o_g)).astype(h.dtype) * jax.nn.silu(gr)
    out = jnp.concatenate([swa, gla], axis=-1) @ w_out
    return out, (k, v, jnp.stack([s_f, s_b], axis=1))


def _odd_latent(h, rope, w_in, w_out, sink, w2, b2, ck, cv, st_gla):
    B, T, _ = h.shape
    sq, sk, sv, gq, gk, gv, gr, glr = _split(h @ w_in, ODD_SPLITS)
    q = _apply_axial_rope(_heads(sq, H_SWA), rope).reshape(B, KV_SWA, SWA_GROUP, T, DH_SWA)
    k = _apply_axial_rope(_heads(sk, KV_SWA), rope)
    v = _heads(sv, KV_SWA)
    swa = _merge_heads(_banded_sink_attention(q, k, v, ck, cv, sink))
    o_g, _, _ = _bidir_gla(_heads(gq, H_GLA) * DK_GLA ** -0.5, _heads(gk, H_GLA), _heads(gv, H_GLA),
                           _gla_log_gates(glr, w2, b2), st_gla[:, 0], st_gla[:, 1])
    gla = _merge_heads(_head_norm(o_g)).astype(h.dtype) * jax.nn.silu(gr)
    return jnp.concatenate([swa, gla], axis=-1) @ w_out, ()


def _block(x, mod, mixer, g, b, w1, w2):
    sh1, sc1, gt1, sh2, sc2, gt2 = jnp.split(mod, 6, axis=-1)
    mix, aux = mixer(x * (1 + sc1) + sh1)
    x = _layer_norm(ALPHA * x + gt1 * mix, g[0], b[0])
    hf = x * (1 + sc2) + sh2
    ff = jnp.square(jax.nn.relu(hf @ w1)) @ w2
    x = _layer_norm(ALPHA * x + gt2 * ff, g[1], b[1])
    return x, aux


def setup_inputs(seed: int = 0) -> dict:
    key = jax.random.key(seed)
    ks = jax.random.split(key, 26)
    f32 = jnp.float32
    nrm = lambda k, shape, s: jax.random.normal(k, shape, f32) * s
    D, L = D_MODEL, PAST_LEN
    ret_base = jnp.asarray(np.log(-np.log1p(-(2.0 ** (-5.0 - np.arange(H_RET)))))).astype(f32)
    return {
        'x_prompt': nrm(ks[0], (BATCH, SEQ, D), 1.0),
        'x_sample': nrm(ks[1], (DEC_BATCH, DEC_SEQ, D), 1.0),
        'c': nrm(ks[2], (DEC_BATCH, D), 1.0),
        'state_ret': nrm(ks[3], (DEC_BATCH, N_EVEN, 2, H_RET, DK_RET, DV_RET), 0.5),
        'cache_diff_k': nrm(ks[4], (DEC_BATCH, N_EVEN, H_DIFF, 2, L, DH_DIFF), 1.0),
        'cache_diff_v': nrm(ks[5], (DEC_BATCH, N_EVEN, H_DIFF, L, DV_DIFF), 1.0),
        'cache_swa_k': nrm(ks[6], (DEC_BATCH, N_ODD, KV_SWA, L, DH_SWA), 1.0),
        'cache_swa_v': nrm(ks[7], (DEC_BATCH, N_ODD, KV_SWA, L, DH_SWA), 1.0),
        'state_gla': nrm(ks[8], (DEC_BATCH, N_ODD, 2, H_GLA, DK_GLA, DV_GLA), 0.5),
        'c_ctx': nrm(ks[9], (D,), 1.0),
        'w_mod': nrm(ks[10], (DEPTH, D, 6 * D), 0.5 * D ** -0.5),
        'b_mod': nrm(ks[11], (DEPTH, 6 * D), 0.02),
        'ln_g': 1.0 + nrm(ks[12], (DEPTH, 2, D), 0.02),
        'ln_b': nrm(ks[13], (DEPTH, 2, D), 0.02),
        'w_in_even': nrm(ks[14], (N_EVEN, D, EVEN_IN), D ** -0.5),
        'w_out_even': nrm(ks[15], (N_EVEN, EVEN_OUT, D), BETA * EVEN_OUT ** -0.5),
        'ret_decay': ret_base[None, None, :] + nrm(ks[16], (N_EVEN, 2, H_RET), 0.05),
        'diff_lam': nrm(ks[17], (N_EVEN, 4, DH_DIFF), 0.1),
        'w_in_odd': nrm(ks[18], (N_ODD, D, ODD_IN), D ** -0.5),
        'w_out_odd': nrm(ks[19], (N_ODD, ODD_OUT, D), BETA * ODD_OUT ** -0.5),
        'swa_sink': nrm(ks[20], (N_ODD, H_SWA), 0.5),
        'gla_w2': nrm(ks[21], (N_ODD, 2, GLA_RANK, H_GLA * DK_GLA), GLA_RANK ** -0.5),
        'gla_b': nrm(ks[22], (N_ODD, 2, H_GLA * DK_GLA), 0.1),
        'w_ff1': nrm(ks[23], (DEPTH, D, D_FF), D ** -0.5),
        'w_ff2': nrm(ks[24], (DEPTH, D_FF, D), BETA * D_FF ** -0.5),
    }


def reference(x_prompt, x_sample, c, state_ret, cache_diff_k, cache_diff_v, cache_swa_k, cache_swa_v,
              state_gla, c_ctx, w_mod, b_mod, ln_g, ln_b, w_in_even, w_out_even, ret_decay, diff_lam,
              w_in_odd, w_out_odd, swa_sink, gla_w2, gla_b, w_ff1, w_ff2):
    T = x_sample.shape[1]
    rows = T // GRID_W
    rope_diff = _axial_rope(rows, DH_DIFF)
    rope_swa = _axial_rope(rows, DH_SWA)
    mod_ctx = jnp.einsum('d,lde->le', jax.nn.silu(c_ctx), w_mod) + b_mod
    mod_lat = jnp.einsum('bd,lde->lbe', jax.nn.silu(c), w_mod) + b_mod[:, None, :]
    xp, xs = x_prompt, x_sample
    new_ret, new_dk, new_dv, new_sk, new_sv, new_gla = [], [], [], [], [], []
    for l in range(DEPTH):
        mc = mod_ctx[l][None, None, :]
        ml = mod_lat[l][:, None, :]
        if l % 2 == 0:
            e = l // 2
            log_g = -jnp.exp(ret_decay[e].astype(jnp.float32))
            lam_init = 0.8 - 0.6 * math.exp(-0.3 * l)
            lam = _diff_lambda(diff_lam[e], lam_init)
            ctx_mix = functools.partial(_even_ctx, w_in=w_in_even[e], w_out=w_out_even[e], log_g=log_g,
                                        lam=lam, lam_init=lam_init)
            xp, (s_r, k_c, v_c) = _block(xp, mc, ctx_mix, ln_g[l], ln_b[l], w_ff1[l], w_ff2[l])
            new_ret.append(s_r)
            new_dk.append(k_c)
            new_dv.append(v_c)
            lat_mix = functools.partial(_even_latent, rope=rope_diff, w_in=w_in_even[e], w_out=w_out_even[e],
                                        log_g=log_g, lam=lam, lam_init=lam_init, st_ret=state_ret[:, e],
                                        ck=cache_diff_k[:, e], cv=cache_diff_v[:, e])
            xs, _ = _block(xs, ml, lat_mix, ln_g[l], ln_b[l], w_ff1[l], w_ff2[l])
        else:
            o = l // 2
            ctx_mix = functools.partial(_odd_ctx, w_in=w_in_odd[o], w_out=w_out_odd[o], sink=swa_sink[o],
                                        w2=gla_w2[o], b2=gla_b[o])
            xp, (k_c, v_c, s_g) = _block(xp, mc, ctx_mix, ln_g[l], ln_b[l], w_ff1[l], w_ff2[l])
            new_sk.append(k_c)
            new_sv.append(v_c)
            new_gla.append(s_g)
            lat_mix = functools.partial(_odd_latent, rope=rope_swa, w_in=w_in_odd[o], w_out=w_out_odd[o],
                                        sink=swa_sink[o], w2=gla_w2[o], b2=gla_b[o], ck=cache_swa_k[:, o],
                                        cv=cache_swa_v[:, o], st_gla=state_gla[:, o])
            xs, _ = _block(xs, ml, lat_mix, ln_g[l], ln_b[l], w_ff1[l], w_ff2[l])
    state_ret_new = jnp.stack(new_ret, axis=1)
    cache_diff_k_new = jnp.stack(new_dk, axis=1)
    cache_diff_v_new = jnp.stack(new_dv, axis=1)
    cache_swa_k_new = jnp.stack(new_sk, axis=1)
    cache_swa_v_new = jnp.stack(new_sv, axis=1)
    state_gla_new = jnp.stack(new_gla, axis=1)
    return (xp, xs, state_ret_new, cache_diff_k_new, cache_diff_v_new, cache_swa_k_new, cache_swa_v_new, state_gla_new)
```

```cpp
#include <hip/hip_runtime.h>
#include <hip/hip_cooperative_groups.h>
#include <cstdio>
namespace cg = cooperative_groups;

typedef unsigned short u16;
typedef __bf16 b16x8 __attribute__((ext_vector_type(8)));
typedef __bf16 b16x2 __attribute__((ext_vector_type(2)));
typedef float f32x16 __attribute__((ext_vector_type(16)));
typedef float f32x4 __attribute__((ext_vector_type(4)));
typedef float f32x2 __attribute__((ext_vector_type(2)));
typedef unsigned u32x4 __attribute__((ext_vector_type(4)));
typedef unsigned u32x2 __attribute__((ext_vector_type(2)));

#define DI __device__ __forceinline__
#define MFMA(a, b, c) __builtin_amdgcn_mfma_f32_32x32x16_bf16((a), (b), (c), 0, 0, 0)

#ifndef ONE_LAUNCH
#define ONE_LAUNCH 1
#endif

constexpr int D = 1024, FF = 4096, MC = 4096, MTOK = 12288, LDP = 3072;
constexpr int NPH = 38;
constexpr float ALPHA = 1.681792830507429f;
constexpr float LOG2E = 1.4426950408889634f;

constexpr size_t WS_WT_IN_E = 0;
constexpr size_t WS_WT_OUT_E = WS_WT_IN_E + (size_t)2 * 3072 * 1024 * 2;
constexpr size_t WS_WT_IN_O = WS_WT_OUT_E + (size_t)2 * 1024 * 1024 * 2;
constexpr size_t WS_WT_OUT_O = WS_WT_IN_O + (size_t)2 * 2432 * 1024 * 2;
constexpr size_t WS_WT_FF1 = WS_WT_OUT_O + (size_t)2 * 1024 * 1024 * 2;
constexpr size_t WS_WT_FF2 = WS_WT_FF1 + (size_t)4 * 4096 * 1024 * 2;
constexpr size_t WS_CK_DIFF = WS_WT_FF2 + (size_t)4 * 4096 * 1024 * 2;
constexpr size_t WS_CVT_DIFF = WS_CK_DIFF + (size_t)4 * 2 * 4 * 2 * 256 * 64 * 2;
constexpr size_t WS_CK_SWA = WS_CVT_DIFF + (size_t)4 * 2 * 4 * 128 * 256 * 2;
constexpr size_t WS_CVT_SWA = WS_CK_SWA + (size_t)4 * 2 * 2 * 256 * 64 * 2;
constexpr size_t WS_MOD = WS_CVT_SWA + (size_t)4 * 2 * 2 * 64 * 256 * 2;
constexpr size_t WS_ROPE = WS_MOD + (size_t)4 * 5 * 6144 * 4;
constexpr size_t WS_H = WS_ROPE + (size_t)2048 * 32 * 2 * 4;
constexpr size_t WS_PROJ = WS_H + (size_t)MTOK * 1024 * 2;
constexpr size_t WS_PROJT = WS_PROJ + (size_t)MTOK * LDP * 2;
constexpr size_t WS_FFH = WS_PROJ;
constexpr size_t WS_LIN_U = WS_PROJT + (size_t)1280 * MTOK * 2;
constexpr size_t WS_LIN_S = WS_LIN_U + (size_t)1536 * 8192 * 4;
constexpr size_t WS_LIN_DEC = WS_LIN_S + (size_t)1536 * 8192 * 2;
constexpr size_t WS_END = WS_LIN_DEC + (size_t)1536 * 64 * 4;
static_assert(WS_PROJ + (size_t)MTOK * FF * 2 <= WS_LIN_U, "FFH alias overflow");

constexpr size_t OUT_X = 0;
constexpr size_t OUT_STATE_RET = 12582912;
constexpr size_t OUT_DIFF_K = 14680064;
constexpr size_t OUT_DIFF_V = 18874368;
constexpr size_t OUT_SWA_K = 23068672;
constexpr size_t OUT_SWA_V = 24117248;
constexpr size_t OUT_STATE_GLA = 25165824;

struct Params {
  const float *x_prompt, *x_sample, *c, *state_ret, *cache_diff_k, *cache_diff_v, *cache_swa_k, *cache_swa_v, *state_gla, *c_ctx,
      *w_mod, *b_mod, *ln_g, *ln_b, *w_in_even, *w_out_even, *ret_decay, *diff_lam, *w_in_odd, *w_out_odd, *swa_sink, *gla_w2,
      *gla_b, *w_ff1, *w_ff2;
  float* out;
  char* ws;
  int ph_lo, ph_hi;
};

DI int tid_() { int t = threadIdx.x; asm volatile("" : "+v"(t)); return t; }
DI int bid_() { int b = blockIdx.x; asm volatile("" : "+s"(b)); return b; }
DI unsigned pk2(float a, float b) {
  b16x2 v = __builtin_convertvector((f32x2){a, b}, b16x2);
  return __builtin_bit_cast(unsigned, v);
}
DI float bflo(unsigned u) { return __uint_as_float(u << 16); }
DI float bfhi(unsigned u) { return __uint_as_float(u & 0xffff0000u); }
DI float bf2f(u16 h) { return __uint_as_float(((unsigned)h) << 16); }
DI b16x8 as_b8(u32x4 v) { return __builtin_bit_cast(b16x8, v); }
DI float siluf(float x) { return x / (1.f + __expf(-x)); }
DI int mod_index(int row) { return row < MC ? 0 : 1 + ((row - MC) >> 11); }
DI u32x4 scale8(u32x4 raw, const float* f) {
  u32x4 o;
#pragma unroll
  for (int i = 0; i < 4; ++i) o[i] = pk2(bflo(raw[i]) * f[2 * i], bfhi(raw[i]) * f[2 * i + 1]);
  return o;
}

enum { EPI_PROJ = 0, EPI_RESID = 1, EPI_RELU2 = 2 };

DI int tr_row(bool even, int col) {
  if (even) {
    if (col >= 256 && col < 1024) return col - 256;
    if (col >= 2560 && col < 3072) return col - 2560 + 768;
    return -1;
  }
  if (col >= 640 && col < 768) return col - 640;
  if (col >= 1024 && col < 1792) return col - 1024 + 128;
  return -1;
}

template <int EPI>
DI void gemm_phase(const Params& p, int layer, const u16* __restrict__ A, int lda, const u16* __restrict__ Bt, int K, int tilesN,
                   int goff, char* lds) {
  u16* As = (u16*)lds;
  u16* Bs = As + 2 * 128 * 72;
  const int t = tid_(), l = t & 63, w = t >> 6, wm = w >> 1, wn = w & 1, c = l & 31, hf = l >> 5;
  const int lrow = t >> 3, lch = t & 7;
  const int nk = K >> 6;
  const int ntiles = (MTOK / 128) * tilesN;
  const bool even = (layer & 1) == 0;
  const int eo = layer >> 1;
  float* X = p.out + OUT_X;
  for (int tile = bid_(); tile < ntiles; tile += gridDim.x) {
    const int tm = tile / tilesN, tn = tile - tm * tilesN;
    const u16* Ag = A + (size_t)(tm * 128 + lrow) * lda + lch * 8;
    const u16* Bg = Bt + (size_t)(tn * 128 + lrow) * K + lch * 8;
    f32x16 acc[2][2];
#pragma unroll
    for (int i = 0; i < 2; ++i)
#pragma unroll
      for (int j = 0; j < 2; ++j)
#pragma unroll
        for (int r = 0; r < 16; ++r) acc[i][j][r] = 0.f;
    u32x4 ra[4], rb[4];
#pragma unroll
    for (int i = 0; i < 4; ++i) {
      ra[i] = *(const u32x4*)(Ag + (size_t)i * 32 * lda);
      rb[i] = *(const u32x4*)(Bg + (size_t)i * 32 * K);
    }
#pragma unroll
    for (int i = 0; i < 4; ++i) {
      *(u32x4*)(As + (lrow + 32 * i) * 72 + lch * 8) = ra[i];
      *(u32x4*)(Bs + (lrow + 32 * i) * 72 + lch * 8) = rb[i];
    }
    __syncthreads();
    for (int kt = 0; kt < nk; ++kt) {
      const int cur = kt & 1;
      if (kt + 1 < nk) {
#pragma unroll
        for (int i = 0; i < 4; ++i) {
          ra[i] = *(const u32x4*)(Ag + (size_t)i * 32 * lda + (kt + 1) * 64);
          rb[i] = *(const u32x4*)(Bg + (size_t)i * 32 * K + (kt + 1) * 64);
        }
      }
      const u16* ab = As + cur * 128 * 72 + (wm * 64 + c) * 72 + hf * 8;
      const u16* bb = Bs + cur * 128 * 72 + (wn * 64 + c) * 72 + hf * 8;
#pragma unroll
      for (int ks = 0; ks < 4; ++ks) {
        b16x8 a0 = *(const b16x8*)(ab + ks * 16);
        b16x8 a1 = *(const b16x8*)(ab + 32 * 72 + ks * 16);
        b16x8 b0 = *(const b16x8*)(bb + ks * 16);
        b16x8 b1 = *(const b16x8*)(bb + 32 * 72 + ks * 16);
        acc[0][0] = MFMA(a0, b0, acc[0][0]);
        acc[0][1] = MFMA(a0, b1, acc[0][1]);
        acc[1][0] = MFMA(a1, b0, acc[1][0]);
        acc[1][1] = MFMA(a1, b1, acc[1][1]);
      }
      if (kt + 1 < nk) {
        const int nx = cur ^ 1;
#pragma unroll
        for (int i = 0; i < 4; ++i) {
          *(u32x4*)(As + nx * 128 * 72 + (lrow + 32 * i) * 72 + lch * 8) = ra[i];
          *(u32x4*)(Bs + nx * 128 * 72 + (lrow + 32 * i) * 72 + lch * 8) = rb[i];
        }
      }
      __syncthreads();
    }
    const int rowt = tm * 128;
    if (EPI == EPI_RESID) {
      const float* gate = (const float*)(p.ws + WS_MOD) + (size_t)(layer * 5 + mod_index(rowt)) * 6144 + goff;
#pragma unroll
      for (int mt = 0; mt < 2; ++mt)
#pragma unroll
        for (int nt = 0; nt < 2; ++nt) {
          const int col = tn * 128 + wn * 64 + nt * 32 + c;
          const float g = gate[col];
#pragma unroll
          for (int r = 0; r < 16; ++r) {
            const int row = rowt + wm * 64 + mt * 32 + 8 * (r >> 2) + 4 * hf + (r & 3);
            float* px = X + (size_t)row * D + col;
            *px = ALPHA * (*px) + g * acc[mt][nt][r];
          }
        }
    } else if (EPI == EPI_RELU2) {
      u16* FFH = (u16*)(p.ws + WS_FFH);
#pragma unroll
      for (int mt = 0; mt < 2; ++mt)
#pragma unroll
        for (int nt = 0; nt < 2; ++nt) {
          const int col = tn * 128 + wn * 64 + nt * 32 + c;
#pragma unroll
          for (int r = 0; r < 16; ++r) {
            const int row = rowt + wm * 64 + mt * 32 + 8 * (r >> 2) + 4 * hf + (r & 3);
            float v = fmaxf(acc[mt][nt][r], 0.f);
            FFH[(size_t)row * FF + col] = (u16)(pk2(v * v, 0.f) & 0xffffu);
          }
        }
    } else {
      u16* PROJ = (u16*)(p.ws + WS_PROJ);
      u16* PROJT = (u16*)(p.ws + WS_PROJT);
      const f32x2* ROPE = (const f32x2*)(p.ws + WS_ROPE);
      const bool latent = rowt >= MC;
#pragma unroll
      for (int mt = 0; mt < 2; ++mt)
#pragma unroll
        for (int nt = 0; nt < 2; ++nt) {
          const int colb = tn * 128 + wn * 64 + nt * 32;
          const int col = colb + c;
          const int rowb = rowt + wm * 64 + mt * 32;
          float v[16];
#pragma unroll
          for (int r = 0; r < 16; ++r) v[r] = acc[mt][nt][r];
          const bool rope = latent && (even ? (colb >= 1536 && colb < 2560) : (colb < 640));
          if (rope) {
#pragma unroll
            for (int r = 0; r < 16; ++r) {
              const int row = rowb + 8 * (r >> 2) + 4 * hf + (r & 3);
              const int tpos = (row - MC) & 2047;
              const float partner = __shfl_xor(v[r], 16);
              const f32x2 cs = ROPE[tpos * 32 + nt * 16 + (c & 15)];
              v[r] = (c & 16) ? (v[r] * cs[0] + partner * cs[1]) : (v[r] * cs[0] - partner * cs[1]);
            }
          }
#pragma unroll
          for (int r = 0; r < 16; ++r) {
            const int row = rowb + 8 * (r >> 2) + 4 * hf + (r & 3);
            PROJ[(size_t)row * LDP + col] = (u16)(pk2(v[r], 0.f) & 0xffffu);
          }
          const int trb = tr_row(even, colb);
          if (trb >= 0) {
#pragma unroll
            for (int g = 0; g < 4; ++g) {
              u32x2 pv;
              pv[0] = pk2(v[4 * g], v[4 * g + 1]);
              pv[1] = pk2(v[4 * g + 2], v[4 * g + 3]);
              *(u32x2*)(PROJT + (size_t)(trb + c) * MTOK + rowb + 8 * g + 4 * hf) = pv;
            }
          }
          if (!latent) {
            float* dst = nullptr;
            int ldt = 64;
            const int b = rowb >> 8;
            if (even) {
              if (colb >= 2048 && colb < 2560) {
                const int j = col - 2048;
                dst = p.out + OUT_DIFF_K + ((size_t)((b * 2 + eo) * 8 + (j >> 6)) * 256) * 64 + (j & 63);
              } else if (colb >= 2560) {
                const int j = col - 2560;
                dst = p.out + OUT_DIFF_V + ((size_t)((b * 2 + eo) * 4 + (j >> 7)) * 256) * 128 + (j & 127);
                ldt = 128;
              }
            } else {
              if (colb >= 512 && colb < 640) {
                const int j = col - 512;
                dst = p.out + OUT_SWA_K + ((size_t)((b * 2 + eo) * 2 + (j >> 6)) * 256) * 64 + (j & 63);
              } else if (colb >= 640 && colb < 768) {
                const int j = col - 640;
                dst = p.out + OUT_SWA_V + ((size_t)((b * 2 + eo) * 2 + (j >> 6)) * 256) * 64 + (j & 63);
              }
            }
            if (dst) {
#pragma unroll
              for (int r = 0; r < 16; ++r) {
                const int tt = (rowb & 255) + 8 * (r >> 2) + 4 * hf + (r & 3);
                dst[(size_t)tt * ldt] = v[r];
              }
            }
          }
        }
    }
  }
}

struct KSeg {
  const u16* k0;
  const u16* k1;
  int ldk;
  const u16* vt;
  int ldv;
  int ntiles;
  int kpos0;
  int masked;
};

template <int DV, int NMAP>
DI void attn_gload(const KSeg& s, int j, int t, u32x4 (&rk)[NMAP * 2], u32x4 (&rv)[DV / 32]) {
#pragma unroll
  for (int i = 0; i < 2; ++i) {
    const int idx = t + 256 * i, row = idx >> 3, ch = idx & 7;
    rk[i] = *(const u32x4*)(s.k0 + (size_t)(j * 64 + row) * s.ldk + ch * 8);
    if (NMAP == 2) rk[2 + i] = *(const u32x4*)(s.k1 + (size_t)(j * 64 + row) * s.ldk + ch * 8);
  }
#pragma unroll
  for (int i = 0; i < DV / 32; ++i) {
    const int idx = t + 256 * i, row = idx >> 3, ch = idx & 7;
    rv[i] = *(const u32x4*)(s.vt + (size_t)row * s.ldv + j * 64 + ch * 8);
  }
}

template <int DV, bool DIFF>
DI void attn_item(const u16* q0, const u16* q1, int ldq, const KSeg& sA, const KSeg& sB, int qpos0, float sinkv, bool has_sink,
                  float lam, float outscale, u16* outp, char* lds) {
  constexpr int NMAP = DIFF ? 2 : 1;
  constexpr int NDT = DV / 32;
  u16* Ks = (u16*)lds;
  u16* Vs = Ks + NMAP * 64 * 72;
  float* Ex = (float*)lds;
  const int t = tid_(), l = t & 63, w = t >> 6, c = l & 31, hf = l >> 5;
  const int map = DIFF ? (w >> 1) : 0;
  const int qt = DIFF ? (w & 1) : w;
  const u16* qp = (map ? q1 : q0) + (size_t)(qt * 32 + c) * ldq + hf * 8;
  b16x8 qf[4];
#pragma unroll
  for (int ks = 0; ks < 4; ++ks) qf[ks] = *(const b16x8*)(qp + ks * 16);
  f32x16 O[NDT];
#pragma unroll
  for (int d = 0; d < NDT; ++d)
#pragma unroll
    for (int r = 0; r < 16; ++r) O[d][r] = 0.f;
  float m_run, l_run;
  if (has_sink) {
    m_run = sinkv * LOG2E;
    l_run = hf == 0 ? 1.f : 0.f;
  } else {
    m_run = -INFINITY;
    l_run = 0.f;
  }
  const float SC = 0.125f * LOG2E;
  const int ntot = sA.ntiles + sB.ntiles;
  u32x4 rk[NMAP * 2], rv[NDT];
  if (sA.ntiles > 0) attn_gload<DV, NMAP>(sA, 0, t, rk, rv);
  else attn_gload<DV, NMAP>(sB, 0, t, rk, rv);
  const int qpos = qpos0 + qt * 32 + c;
  for (int it = 0; it < ntot; ++it) {
    __syncthreads();
#pragma unroll
    for (int i = 0; i < 2; ++i) {
      const int idx = t + 256 * i, row = idx >> 3, ch = idx & 7;
      *(u32x4*)(Ks + row * 72 + ch * 8) = rk[i];
      if (NMAP == 2) *(u32x4*)(Ks + (64 + row) * 72 + ch * 8) = rk[2 + i];
    }
#pragma unroll
    for (int i = 0; i < NDT; ++i) {
      const int idx = t + 256 * i, row = idx >> 3, ch = idx & 7;
      *(u32x4*)(Vs + row * 72 + ch * 8) = rv[i];
    }
    __syncthreads();
    if (it + 1 < ntot) {
      const int nx = it + 1;
      if (nx < sA.ntiles) attn_gload<DV, NMAP>(sA, nx, t, rk, rv);
      else attn_gload<DV, NMAP>(sB, nx - sA.ntiles, t, rk, rv);
    }
    const bool inA = it < sA.ntiles;
    const int masked = inA ? sA.masked : sB.masked;
    const int kbase = inA ? (sA.kpos0 + it * 64) : (sB.kpos0 + (it - sA.ntiles) * 64);
    f32x16 s0, s1;
#pragma unroll
    for (int r = 0; r < 16; ++r) { s0[r] = 0.f; s1[r] = 0.f; }
    const u16* kb = Ks + map * 64 * 72 + c * 72 + hf * 8;
#pragma unroll
    for (int ks = 0; ks < 4; ++ks) {
      b16x8 a0 = *(const b16x8*)(kb + ks * 16);
      b16x8 a1 = *(const b16x8*)(kb + 32 * 72 + ks * 16);
      s0 = MFMA(a0, qf[ks], s0);
      s1 = MFMA(a1, qf[ks], s1);
    }
    float mx = -INFINITY;
#pragma unroll
    for (int r = 0; r < 16; ++r) {
      float v0 = s0[r] * SC, v1 = s1[r] * SC;
      if (!DIFF && masked) {
        const int d0 = qpos - (kbase + 8 * (r >> 2) + 4 * hf + (r & 3));
        const int d1 = d0 - 32;
        if (d0 > 128 || d0 < -128) v0 = -INFINITY;
        if (d1 > 128 || d1 < -128) v1 = -INFINITY;
      }
      s0[r] = v0;
      s1[r] = v1;
      mx = fmaxf(mx, fmaxf(v0, v1));
    }
    mx = fmaxf(mx, __shfl_xor(mx, 32));
    const float m_new = fmaxf(m_run, mx);
    const float alpha = __builtin_amdgcn_exp2f(m_run - m_new);
    m_run = m_new;
    float rs = 0.f;
#pragma unroll
    for (int r = 0; r < 16; ++r) {
      s0[r] = __builtin_amdgcn_exp2f(s0[r] - m_new);
      s1[r] = __builtin_amdgcn_exp2f(s1[r] - m_new);
      rs += s0[r] + s1[r];
    }
    l_run = l_run * alpha + rs;
#pragma unroll
    for (int d = 0; d < NDT; ++d)
#pragma unroll
      for (int r = 0; r < 16; ++r) O[d][r] *= alpha;
#pragma unroll
    for (int mt = 0; mt < 2; ++mt) {
#pragma unroll
      for (int u = 0; u < 2; ++u) {
        u32x4 pr;
#pragma unroll
        for (int i = 0; i < 4; ++i)
          pr[i] = mt == 0 ? pk2(s0[8 * u + 2 * i], s0[8 * u + 2 * i + 1]) : pk2(s1[8 * u + 2 * i], s1[8 * u + 2 * i + 1]);
        const b16x8 pb = as_b8(pr);
#pragma unroll
        for (int d = 0; d < NDT; ++d) {
          const u16* vb = Vs + (d * 32 + c) * 72 + mt * 32 + 16 * u + 4 * hf;
          const u32x2 lo = *(const u32x2*)vb;
          const u32x2 hi = *(const u32x2*)(vb + 8);
          u32x4 av;
          av[0] = lo[0]; av[1] = lo[1]; av[2] = hi[0]; av[3] = hi[1];
          O[d] = MFMA(as_b8(av), pb, O[d]);
        }
      }
    }
  }
  const float ltot = l_run + __shfl_xor(l_run, 32);
  const float inv = 1.f / ltot;
#pragma unroll
  for (int d = 0; d < NDT; ++d)
#pragma unroll
    for (int r = 0; r < 16; ++r) O[d][r] *= inv;
  if (!DIFF) {
#pragma unroll
    for (int d = 0; d < NDT; ++d)
#pragma unroll
      for (int g = 0; g < 4; ++g) {
        u32x2 pv;
        pv[0] = pk2(O[d][4 * g], O[d][4 * g + 1]);
        pv[1] = pk2(O[d][4 * g + 2], O[d][4 * g + 3]);
        *(u32x2*)(outp + (size_t)(qt * 32 + c) * D + d * 32 + 8 * g + 4 * hf) = pv;
      }
  } else {
    __syncthreads();
    if (map == 1) {
#pragma unroll
      for (int d = 0; d < NDT; ++d)
#pragma unroll
        for (int g = 0; g < 4; ++g) {
          f32x4 v = {O[d][4 * g], O[d][4 * g + 1], O[d][4 * g + 2], O[d][4 * g + 3]};
          *(f32x4*)(Ex + (qt * 32 + c) * (DV + 4) + d * 32 + 8 * g + 4 * hf) = v;
        }
    }
    __syncthreads();
    if (map == 0) {
      float sum = 0.f;
#pragma unroll
      for (int d = 0; d < NDT; ++d)
#pragma unroll
        for (int g = 0; g < 4; ++g) {
          const f32x4 v = *(const f32x4*)(Ex + (qt * 32 + c) * (DV + 4) + d * 32 + 8 * g + 4 * hf);
#pragma unroll
          for (int i = 0; i < 4; ++i) {
            O[d][4 * g + i] -= lam * v[i];
            sum += O[d][4 * g + i];
          }
        }
      sum += __shfl_xor(sum, 32);
      const float mean = sum * (1.f / DV);
      float sq = 0.f;
#pragma unroll
      for (int d = 0; d < NDT; ++d)
#pragma unroll
        for (int r = 0; r < 16; ++r) {
          const float dlt = O[d][r] - mean;
          sq += dlt * dlt;
        }
      sq += __shfl_xor(sq, 32);
      const float rstd = rsqrtf(sq * (1.f / DV) + 1e-5f) * outscale;
#pragma unroll
      for (int d = 0; d < NDT; ++d)
#pragma unroll
        for (int g = 0; g < 4; ++g) {
          u32x2 pv;
          pv[0] = pk2((O[d][4 * g] - mean) * rstd, (O[d][4 * g + 1] - mean) * rstd);
          pv[1] = pk2((O[d][4 * g + 2] - mean) * rstd, (O[d][4 * g + 3] - mean) * rstd);
          *(u32x2*)(outp + (size_t)(qt * 32 + c) * D + d * 32 + 8 * g + 4 * hf) = pv;
        }
    }
  }
}

struct LinCfg {
  int qcol, kcol, ktb, vtb, gcol, mixcol;
  float qscale, kscale;
  bool gla;
};
DI LinCfg lin_cfg(bool even) {
  LinCfg c;
  if (even) { c.qcol = 0; c.kcol = 256; c.ktb = 0; c.vtb = 256; c.gcol = 1024; c.mixcol = 0; c.qscale = 1.f; c.kscale = 0.125f; c.gla = false; }
  else { c.qcol = 768; c.kcol = 1024; c.ktb = 128; c.vtb = 384; c.gcol = 1792; c.mixcol = 512; c.qscale = 0.125f; c.kscale = 1.f; c.gla = true; }
  return c;
}

DI void fill_B(const Params& p, int layer, int tok0, int h, int dir, float* Bl, float* scr) {
  const int t = tid_();
  const bool even = (layer & 1) == 0;
  const int eo = layer >> 1;
  __syncthreads();
  if (even) {
    const float lg = -__expf(p.ret_decay[(eo * 2 + dir) * 4 + h]);
    for (int idx = t; idx < 4096; idx += 256) {
      const int j = idx >> 6, dd = idx & 63;
      Bl[j * 65 + dd] = (float)(dir ? (64 - j) : (j + 1)) * lg;
    }
    __syncthreads();
    return;
  }
  const u16* glr = (const u16*)(p.ws + WS_PROJ) + (size_t)tok0 * LDP + 2304 + dir * 16;
  for (int idx = t; idx < 1024; idx += 256) scr[idx] = bf2f(glr[(size_t)(idx >> 4) * LDP + (idx & 15)]);
  __syncthreads();
  {
    const int dd = t & 63, jq = t >> 6;
    const float* w2 = p.gla_w2 + (size_t)((eo * 2 + dir) * 16) * 256 + h * 64 + dd;
    float wv[16];
#pragma unroll
    for (int r = 0; r < 16; ++r) wv[r] = w2[r * 256];
    const float bb = p.gla_b[(eo * 2 + dir) * 256 + h * 64 + dd];
#pragma unroll 4
    for (int jj = 0; jj < 16; ++jj) {
      const int j = jq * 16 + jj;
      float z = bb;
#pragma unroll
      for (int r = 0; r < 16; ++r) z += scr[j * 16 + r] * wv[r];
      const float ls = fminf(z, 0.f) - log1pf(__expf(-fabsf(z)));
      Bl[j * 65 + dd] = ls * (1.f / 16.f);
    }
  }
  __syncthreads();
  if (t < 64) {
    float run = 0.f;
    if (!dir) {
      for (int j = 0; j < 64; ++j) { run += Bl[j * 65 + t]; Bl[j * 65 + t] = run; }
    } else {
      for (int j = 63; j >= 0; --j) { run += Bl[j * 65 + t]; Bl[j * 65 + t] = run; }
    }
  }
  __syncthreads();
}

DI void lin_g1_item(const Params& p, int layer, int item, char* lds) {
  float* Bl = (float*)lds;
  float* scr = Bl + 64 * 65;
  const int t = tid_(), l = t & 63, w = t >> 6, c = l & 31, hf = l >> 5;
  const int dir = item & 1, h = (item >> 1) & 3, cgi = item >> 3;
  const int tok0 = cgi * 64;
  const LinCfg cf = lin_cfg((layer & 1) == 0);
  fill_B(p, layer, tok0, h, dir, Bl, scr);
  const u16* PROJT = (const u16*)(p.ws + WS_PROJT);
  f32x16 acc[2];
#pragma unroll
  for (int i = 0; i < 2; ++i)
#pragma unroll
    for (int r = 0; r < 16; ++r) acc[i][r] = 0.f;
  const int brow = dir ? 0 : 63;
#pragma unroll
  for (int ks = 0; ks < 4; ++ks) {
    const int tk = ks * 16 + hf * 8;
    const b16x8 a = *(const b16x8*)(PROJT + (size_t)(cf.vtb + h * 128 + w * 32 + c) * MTOK + tok0 + tk);
#pragma unroll
    for (int nt = 0; nt < 2; ++nt) {
      const int dd = nt * 32 + c;
      const u32x4 raw = *(const u32x4*)(PROJT + (size_t)(cf.ktb + h * 64 + dd) * MTOK + tok0 + tk);
      const float btot = Bl[brow * 65 + dd];
      float f[8];
#pragma unroll
      for (int j = 0; j < 8; ++j) f[j] = __expf(btot - Bl[(tk + j) * 65 + dd]) * cf.kscale;
      acc[nt] = MFMA(a, as_b8(scale8(raw, f)), acc[nt]);
    }
  }
  float* U = (float*)(p.ws + WS_LIN_U) + (size_t)item * 8192;
#pragma unroll
  for (int nt = 0; nt < 2; ++nt)
#pragma unroll
    for (int r = 0; r < 16; ++r) U[(w * 32 + 8 * (r >> 2) + 4 * hf + (r & 3)) * 64 + nt * 32 + c] = acc[nt][r];
  if (t < 64) ((float*)(p.ws + WS_LIN_DEC))[(size_t)item * 64 + t] = __expf(Bl[brow * 65 + t]);
}

DI void lin_scan_item(const Params& p, int layer, int item) {
  const int t = tid_();
  const int unit = item >> 5, slab = item & 31;
  const int s = unit < 32 ? 16 + (unit >> 3) : ((unit - 32) >> 3);
  const int h = (unit >> 1) & 3, dir = unit & 1;
  const bool even = (layer & 1) == 0;
  const int eo = layer >> 1;
  const int elem = slab * 256 + t, dv = elem >> 6, dd = elem & 63;
  const int N = s < 16 ? 4 : 32;
  const int cg0 = s < 16 ? s * 4 : 64 + (s - 16) * 32;
  float S = 0.f;
  if (s >= 16) {
    const float* st = even ? p.state_ret : p.state_gla;
    S = st[((size_t)((((s - 16) * 2 + eo) * 2 + dir) * 4 + h) * 64 + dd) * 128 + dv];
  }
  const float* U = (const float*)(p.ws + WS_LIN_U);
  const float* DEC = (const float*)(p.ws + WS_LIN_DEC);
  u16* SP = (u16*)(p.ws + WS_LIN_S);
  for (int step = 0; step < N; ++step) {
    const int n = dir ? N - 1 - step : step;
    const size_t it = (size_t)((cg0 + n) * 4 + h) * 2 + dir;
    SP[it * 8192 + elem] = (u16)(pk2(S, 0.f) & 0xffffu);
    S = DEC[it * 64 + dd] * S + U[it * 8192 + elem];
  }
  if (s < 16) {
    float* o = p.out + (even ? OUT_STATE_RET : OUT_STATE_GLA);
    o[((size_t)(((s * 2 + eo) * 2 + dir) * 4 + h) * 64 + dd) * 128 + dv] = S;
  }
}

DI void lin_g3_item(const Params& p, int layer, int item, char* lds) {
  float* Bl = (float*)lds;
  float* scr = Bl + 64 * 65;
  float* red = scr + 1024;
  const int t = tid_(), l = t & 63, w = t >> 6, c = l & 31, hf = l >> 5;
  const int h = item & 3, cgi = item >> 2;
  const int tok0 = cgi * 64;
  const int tt = w & 1, dh = w >> 1;
  const LinCfg cf = lin_cfg((layer & 1) == 0);
  const u16* PROJ = (const u16*)(p.ws + WS_PROJ);
  const u16* PROJT = (const u16*)(p.ws + WS_PROJT);
  const u16* SP = (const u16*)(p.ws + WS_LIN_S);
  f32x16 O[2];
#pragma unroll
  for (int i = 0; i < 2; ++i)
#pragma unroll
    for (int r = 0; r < 16; ++r) O[i][r] = 0.f;
  const int tl = tt * 32 + c;
#pragma unroll 1
  for (int dir = 0; dir < 2; ++dir) {
    fill_B(p, layer, tok0, h, dir, Bl, scr);
    const size_t it = (size_t)(cgi * 4 + h) * 2 + dir;
    f32x16 P[2];
#pragma unroll
    for (int i = 0; i < 2; ++i)
#pragma unroll
      for (int r = 0; r < 16; ++r) P[i][r] = 0.f;
    u32x4 qs[4];
#pragma unroll
    for (int ks = 0; ks < 4; ++ks) {
      const int dd0 = ks * 16 + hf * 8;
      const u32x4 rawq = *(const u32x4*)(PROJ + (size_t)(tok0 + tl) * LDP + cf.qcol + h * 64 + dd0);
      float bm[8], f1[8], f2[8];
#pragma unroll
      for (int j = 0; j < 8; ++j) {
        bm[j] = Bl[32 * 65 + dd0 + j];
        const float bq = Bl[tl * 65 + dd0 + j];
        f1[j] = __expf(bq) * cf.qscale;
        f2[j] = __expf(bq - bm[j]) * cf.qscale;
      }
      qs[ks] = scale8(rawq, f1);
      const b16x8 qtl = as_b8(scale8(rawq, f2));
#pragma unroll
      for (int mt = 0; mt < 2; ++mt) {
        const int sI = mt * 32 + c;
        const u32x4 rawk = *(const u32x4*)(PROJ + (size_t)(tok0 + sI) * LDP + cf.kcol + h * 64 + dd0);
        float fk[8];
#pragma unroll
        for (int j = 0; j < 8; ++j) fk[j] = __expf(bm[j] - Bl[sI * 65 + dd0 + j]) * cf.kscale;
        P[mt] = MFMA(as_b8(scale8(rawk, fk)), qtl, P[mt]);
      }
    }
#pragma unroll
    for (int mt = 0; mt < 2; ++mt)
#pragma unroll
      for (int r = 0; r < 16; ++r) {
        const int sI = mt * 32 + 8 * (r >> 2) + 4 * hf + (r & 3);
        const bool valid = dir ? (sI >= tl) : (sI <= tl);
        P[mt][r] = valid ? P[mt][r] : 0.f;
      }
#pragma unroll
    for (int mt = 0; mt < 2; ++mt)
#pragma unroll
      for (int u = 0; u < 2; ++u) {
        u32x4 pr;
#pragma unroll
        for (int i = 0; i < 4; ++i) pr[i] = pk2(P[mt][8 * u + 2 * i], P[mt][8 * u + 2 * i + 1]);
        const b16x8 pb = as_b8(pr);
#pragma unroll
        for (int dt = 0; dt < 2; ++dt) {
          const u16* vp = PROJT + (size_t)(cf.vtb + h * 128 + dh * 64 + dt * 32 + c) * MTOK + tok0 + mt * 32 + 16 * u + 4 * hf;
          const u32x2 lo = *(const u32x2*)vp;
          const u32x2 hi = *(const u32x2*)(vp + 8);
          u32x4 av;
          av[0] = lo[0]; av[1] = lo[1]; av[2] = hi[0]; av[3] = hi[1];
          O[dt] = MFMA(as_b8(av), pb, O[dt]);
        }
      }
#pragma unroll
    for (int ks = 0; ks < 4; ++ks)
#pragma unroll
      for (int dt = 0; dt < 2; ++dt) {
        const b16x8 a = *(const b16x8*)(SP + it * 8192 + (size_t)(dh * 64 + dt * 32 + c) * 64 + ks * 16 + hf * 8);
        O[dt] = MFMA(a, as_b8(qs[ks]), O[dt]);
      }
  }
  float sum = 0.f;
#pragma unroll
  for (int dt = 0; dt < 2; ++dt)
#pragma unroll
    for (int r = 0; r < 16; ++r) sum += O[dt][r];
  sum += __shfl_xor(sum, 32);
  __syncthreads();
  if (hf == 0) red[w * 32 + c] = sum;
  __syncthreads();
  const float mean = (red[w * 32 + c] + red[(w ^ 2) * 32 + c]) * (1.f / 128.f);
  float sq = 0.f;
#pragma unroll
  for (int dt = 0; dt < 2; ++dt)
#pragma unroll
    for (int r = 0; r < 16; ++r) {
      const float d = O[dt][r] - mean;
      sq += d * d;
    }
  sq += __shfl_xor(sq, 32);
  if (hf == 0) red[128 + w * 32 + c] = sq;
  __syncthreads();
  const float rstd = rsqrtf((red[128 + w * 32 + c] + red[128 + (w ^ 2) * 32 + c]) * (1.f / 128.f) + 1e-5f);
  u16* MIX = (u16*)(p.ws + WS_H);
#pragma unroll
  for (int dt = 0; dt < 2; ++dt)
#pragma unroll
    for (int g = 0; g < 4; ++g) {
      const int dvi = dh * 64 + dt * 32 + 8 * g + 4 * hf;
      const u32x2 gr = *(const u32x2*)(PROJ + (size_t)(tok0 + tl) * LDP + cf.gcol + h * 128 + dvi);
      const float g0 = siluf(bflo(gr[0])), g1 = siluf(bfhi(gr[0])), g2 = siluf(bflo(gr[1])), g3 = siluf(bfhi(gr[1]));
      u32x2 pv;
      pv[0] = pk2((O[dt][4 * g] - mean) * rstd * g0, (O[dt][4 * g + 1] - mean) * rstd * g1);
      pv[1] = pk2((O[dt][4 * g + 2] - mean) * rstd * g2, (O[dt][4 * g + 3] - mean) * rstd * g3);
      *(u32x2*)(MIX + (size_t)(tok0 + tl) * D + cf.mixcol + h * 128 + dvi) = pv;
    }
}

DI void mix_phase(const Params& p, int layer, char* lds) {
  const bool even = (layer & 1) == 0;
  const int eo = layer >> 1;
  const u16* PROJ = (const u16*)(p.ws + WS_PROJ);
  const u16* PROJT = (const u16*)(p.ws + WS_PROJT);
  u16* MIX = (u16*)(p.ws + WS_H);
  float lam = 0.f, lam_init = 0.f;
  if (even) {
    lam_init = layer == 0 ? 0.2f : 0.47071301834358414f;
    const float* dl = p.diff_lam + eo * 256;
    float s1 = 0.f, s2 = 0.f;
    for (int i = 0; i < 64; ++i) { s1 += dl[i] * dl[64 + i]; s2 += dl[128 + i] * dl[192 + i]; }
    lam = __expf(s1) - __expf(s2) + lam_init;
  }
  const int nitems = 512 + 256 + 1536;
  if (even) {
    for (int item = bid_(); item < nitems; item += gridDim.x) {
      if (item >= 768) { lin_g1_item(p, layer, item - 768, lds); continue; }
      KSeg sA, sB;
      sB.k0 = sB.k1 = sB.vt = nullptr; sB.ldk = sB.ldv = 0; sB.ntiles = 0; sB.kpos0 = 0; sB.masked = 0;
      sA = sB;
      const bool lat = item < 512;
      const int i2 = lat ? item : item - 512;
      const int b = lat ? (i2 >> 7) : (i2 >> 4), h = lat ? ((i2 >> 5) & 3) : ((i2 >> 2) & 3), qb = lat ? (i2 & 31) : (i2 & 3);
      const size_t row0 = lat ? MC + (size_t)b * 2048 : (size_t)b * 256;
      KSeg own;
      own.k0 = PROJ + row0 * LDP + 2048 + h * 128; own.k1 = own.k0 + 64; own.ldk = LDP;
      own.vt = PROJT + (size_t)(768 + h * 128) * MTOK + row0; own.ldv = MTOK; own.ntiles = lat ? 32 : 4; own.kpos0 = 0; own.masked = 0;
      if (lat) {
        const u16* ck = (const u16*)(p.ws + WS_CK_DIFF) + (size_t)(((b * 2 + eo) * 4 + h) * 2) * 256 * 64;
        sA.k0 = ck; sA.k1 = ck + 256 * 64; sA.ldk = 64;
        sA.vt = (const u16*)(p.ws + WS_CVT_DIFF) + (size_t)((b * 2 + eo) * 4 + h) * 128 * 256; sA.ldv = 256; sA.ntiles = 4;
        sB = own;
      } else {
        sA = own;
      }
      const u16* q0 = PROJ + (row0 + qb * 64) * LDP + 1536 + h * 128;
      attn_item<128, true>(q0, q0 + 64, LDP, sA, sB, 0, 0.f, false, lam, 1.f - lam_init,
                           MIX + (row0 + qb * 64) * D + 512 + h * 128, lds);
    }
  } else {
    for (int item = bid_(); item < nitems; item += gridDim.x) {
      if (item >= 768) { lin_g1_item(p, layer, item - 768, lds); continue; }
      KSeg sA, sB;
      sB.k0 = sB.k1 = sB.vt = nullptr; sB.ldk = sB.ldv = 0; sB.ntiles = 0; sB.kpos0 = 0; sB.masked = 0;
      sA = sB;
      const bool lat = item < 512;
      const int i2 = lat ? item : item - 512;
      const int b = lat ? (i2 >> 7) : (i2 >> 4), h = lat ? ((i2 >> 4) & 7) : ((i2 >> 1) & 7), qb = lat ? (i2 & 15) : (i2 & 1);
      const int kv = h >> 2;
      const size_t row0 = lat ? MC + (size_t)b * 2048 : (size_t)b * 256;
      const int ks = lat ? max(0, qb * 128 - 128) : 0, ke = lat ? min(2048, qb * 128 + 256) : 256;
      KSeg own;
      own.k0 = own.k1 = PROJ + (row0 + ks) * LDP + 512 + kv * 64; own.ldk = LDP;
      own.vt = PROJT + (size_t)(kv * 64) * MTOK + row0 + ks; own.ldv = MTOK; own.ntiles = (ke - ks) >> 6; own.kpos0 = ks; own.masked = lat ? 1 : 0;
      if (lat) {
        sA.k0 = sA.k1 = (const u16*)(p.ws + WS_CK_SWA) + (size_t)((b * 2 + eo) * 2 + kv) * 256 * 64; sA.ldk = 64;
        sA.vt = (const u16*)(p.ws + WS_CVT_SWA) + (size_t)((b * 2 + eo) * 2 + kv) * 64 * 256; sA.ldv = 256; sA.ntiles = 4;
        sB = own;
      } else {
        sA = own;
      }
      const u16* q0 = PROJ + (row0 + qb * 128) * LDP + h * 64;
      attn_item<64, false>(q0, q0, LDP, sA, sB, qb * 128, p.swa_sink[eo * 8 + h], true, 0.f, 1.f,
                           MIX + (row0 + qb * 128) * D + h * 64, lds);
    }
  }
}

DI void ln_phase(const Params& p, int mode, const float* g, const float* b, int hlayer, int shoff, int scoff) {
  const int t = tid_(), l = t & 63, w = t >> 6;
  float* X = p.out + OUT_X;
  u16* H = (u16*)(p.ws + WS_H);
  const float* MOD = (const float*)(p.ws + WS_MOD);
  for (int row = bid_() * 4 + w; row < MTOK; row += gridDim.x * 4) {
    f32x4 v[4];
    if (mode == 1) {
      const float* src = row < MC ? p.x_prompt + (size_t)row * D : p.x_sample + (size_t)(row - MC) * D;
#pragma unroll
      for (int i = 0; i < 4; ++i) v[i] = *(const f32x4*)(src + i * 256 + l * 4);
    } else {
#pragma unroll
      for (int i = 0; i < 4; ++i) v[i] = *(const f32x4*)(X + (size_t)row * D + i * 256 + l * 4);
      float s = 0.f;
#pragma unroll
      for (int i = 0; i < 4; ++i) s += v[i][0] + v[i][1] + v[i][2] + v[i][3];
#pragma unroll
      for (int o = 32; o >= 1; o >>= 1) s += __shfl_xor(s, o);
      const float mean = s * (1.f / D);
      float q = 0.f;
#pragma unroll
      for (int i = 0; i < 4; ++i)
#pragma unroll
        for (int j = 0; j < 4; ++j) { const float d = v[i][j] - mean; q += d * d; }
#pragma unroll
      for (int o = 32; o >= 1; o >>= 1) q += __shfl_xor(q, o);
      const float rstd = rsqrtf(q * (1.f / D) + 1e-5f);
#pragma unroll
      for (int i = 0; i < 4; ++i) {
        const f32x4 gg = *(const f32x4*)(g + i * 256 + l * 4);
        const f32x4 bb = *(const f32x4*)(b + i * 256 + l * 4);
#pragma unroll
        for (int j = 0; j < 4; ++j) v[i][j] = (v[i][j] - mean) * rstd * gg[j] + bb[j];
      }
    }
#pragma unroll
    for (int i = 0; i < 4; ++i) *(f32x4*)(X + (size_t)row * D + i * 256 + l * 4) = v[i];
    if (hlayer >= 0) {
      const float* mp = MOD + (size_t)(hlayer * 5 + mod_index(row)) * 6144;
#pragma unroll
      for (int i = 0; i < 4; ++i) {
        const f32x4 sh = *(const f32x4*)(mp + shoff + i * 256 + l * 4);
        const f32x4 sc = *(const f32x4*)(mp + scoff + i * 256 + l * 4);
        u32x2 pv;
        pv[0] = pk2(v[i][0] * (1.f + sc[0]) + sh[0], v[i][1] * (1.f + sc[1]) + sh[1]);
        pv[1] = pk2(v[i][2] * (1.f + sc[2]) + sh[2], v[i][3] * (1.f + sc[3]) + sh[3]);
        *(u32x2*)(H + (size_t)row * D + i * 256 + l * 4) = pv;
      }
    }
  }
}

DI void prep_transpose_tile(const float* __restrict__ src, int K, int N, u16* __restrict__ dst, int tk, int tn, float* tile) {
  const int t = tid_();
  __syncthreads();
#pragma unroll
  for (int i = 0; i < 2; ++i) {
    const int row = (t >> 3) + 32 * i, c4 = (t & 7) * 4;
    const f32x4 v = *(const f32x4*)(src + (size_t)(tk * 64 + row) * N + tn * 32 + c4);
    tile[row * 33 + c4 + 0] = v[0];
    tile[row * 33 + c4 + 1] = v[1];
    tile[row * 33 + c4 + 2] = v[2];
    tile[row * 33 + c4 + 3] = v[3];
  }
  __syncthreads();
  const int n = t >> 3, kc = (t & 7) * 8;
  u32x4 o;
#pragma unroll
  for (int i = 0; i < 4; ++i) o[i] = pk2(tile[(kc + 2 * i) * 33 + n], tile[(kc + 2 * i + 1) * 33 + n]);
  *(u32x4*)(dst + (size_t)(tn * 32 + n) * K + tk * 64 + kc) = o;
}

DI void prep_mod_item(const Params& p, int item, char* lds) {
  float* sv = (float*)lds;
  float* red = sv + 5 * 1024;
  const int t = tid_();
  const int layer = item / 96, c0 = (item % 96) * 64;
  __syncthreads();
  for (int idx = t; idx < 5 * 1024; idx += 256) {
    const int m = idx >> 10, k = idx & 1023;
    const float x = m == 0 ? p.c_ctx[k] : p.c[(m - 1) * 1024 + k];
    sv[idx] = siluf(x);
  }
  __syncthreads();
  const int c4 = t & 15, kg = t >> 4;
  float acc[5][4];
#pragma unroll
  for (int m = 0; m < 5; ++m)
#pragma unroll
    for (int j = 0; j < 4; ++j) acc[m][j] = 0.f;
  const float* wp = p.w_mod + (size_t)layer * 1024 * 6144 + c0 + c4 * 4;
#pragma unroll 4
  for (int k = kg; k < 1024; k += 16) {
    const f32x4 wv = *(const f32x4*)(wp + (size_t)k * 6144);
#pragma unroll
    for (int m = 0; m < 5; ++m) {
      const float s = sv[m * 1024 + k];
#pragma unroll
      for (int j = 0; j < 4; ++j) acc[m][j] += s * wv[j];
    }
  }
#pragma unroll
  for (int m = 0; m < 5; ++m)
#pragma unroll
    for (int j = 0; j < 4; ++j) red[(kg * 5 + m) * 64 + c4 * 4 + j] = acc[m][j];
  __syncthreads();
  float* MOD = (float*)(p.ws + WS_MOD);
  for (int idx = t; idx < 320; idx += 256) {
    const int m = idx >> 6, cc = idx & 63;
    float s = p.b_mod[layer * 6144 + c0 + cc];
    for (int q = 0; q < 16; ++q) s += red[(q * 5 + m) * 64 + cc];
    MOD[(size_t)(layer * 5 + m) * 6144 + c0 + cc] = s;
  }
}

DI void prep_phase(const Params& p, char* lds) {
  const int t = tid_();
  constexpr int N_MOD = 384, N_TR = 24480, N_CK = 640, N_ROPE = 32;
  for (int item = bid_(); item < N_MOD + N_TR + N_CK + N_ROPE; item += gridDim.x) {
    if (item < N_MOD) {
      prep_mod_item(p, item, lds);
    } else if (item < N_MOD + N_TR) {
      int i = item - N_MOD;
      const float* src; u16* dst; int K, N, per; size_t sstride, dstride;
      if (i < 3072) { src = p.w_in_even; dst = (u16*)(p.ws + WS_WT_IN_E); K = 1024; N = 3072; per = 1536; sstride = (size_t)1024 * 3072; dstride = sstride; }
      else if (i < 4096) { i -= 3072; src = p.w_out_even; dst = (u16*)(p.ws + WS_WT_OUT_E); K = 1024; N = 1024; per = 512; sstride = (size_t)1024 * 1024; dstride = sstride; }
      else if (i < 6432) { i -= 4096; src = p.w_in_odd; dst = (u16*)(p.ws + WS_WT_IN_O); K = 1024; N = 2336; per = 1168; sstride = (size_t)1024 * 2336; dstride = (size_t)2432 * 1024; }
      else if (i < 7456) { i -= 6432; src = p.w_out_odd; dst = (u16*)(p.ws + WS_WT_OUT_O); K = 1024; N = 1024; per = 512; sstride = (size_t)1024 * 1024; dstride = sstride; }
      else if (i < 15648) { i -= 7456; src = p.w_ff1; dst = (u16*)(p.ws + WS_WT_FF1); K = 1024; N = 4096; per = 2048; sstride = (size_t)1024 * 4096; dstride = sstride; }
      else if (i < 23840) { i -= 15648; src = p.w_ff2; dst = (u16*)(p.ws + WS_WT_FF2); K = 4096; N = 1024; per = 2048; sstride = (size_t)1024 * 4096; dstride = sstride; }
      else if (i < 24352) { i -= 23840; src = p.cache_diff_v; dst = (u16*)(p.ws + WS_CVT_DIFF); K = 256; N = 128; per = 16; sstride = (size_t)256 * 128; dstride = sstride; }
      else { i -= 24352; src = p.cache_swa_v; dst = (u16*)(p.ws + WS_CVT_SWA); K = 256; N = 64; per = 8; sstride = (size_t)256 * 64; dstride = sstride; }
      const int mat = i / per, r = i - mat * per;
      const int ntn = N >> 5;
      const int tk = r / ntn, tn = r - tk * ntn;
      prep_transpose_tile(src + mat * sstride, K, N, dst + mat * dstride, tk, tn, (float*)lds);
    } else if (item < N_MOD + N_TR + N_CK) {
      const int i = item - N_MOD - N_TR;
      const float* src; u16* dst; int j;
      if (i < 512) { src = p.cache_diff_k; dst = (u16*)(p.ws + WS_CK_DIFF); j = i; }
      else { src = p.cache_swa_k; dst = (u16*)(p.ws + WS_CK_SWA); j = i - 512; }
      const size_t off = (size_t)j * 2048 + t * 8;
      const f32x4 a = *(const f32x4*)(src + off), b = *(const f32x4*)(src + off + 4);
      u32x4 o;
      o[0] = pk2(a[0], a[1]); o[1] = pk2(a[2], a[3]); o[2] = pk2(b[0], b[1]); o[3] = pk2(b[2], b[3]);
      *(u32x4*)(dst + off) = o;
    } else {
      const int i = item - N_MOD - N_TR - N_CK;
      f32x2* ROPE = (f32x2*)(p.ws + WS_ROPE);
      for (int q = 0; q < 8; ++q) {
        const int idx = i * 2048 + q * 256 + t;
        const int tp = idx >> 5, j = idx & 31;
        const float fr = powf(10000.f, -(float)(j & 15) * (1.f / 16.f));
        const float ang = (float)(j < 16 ? (tp >> 6) : (tp & 63)) * fr;
        float sn, cs;
        sincosf(ang, &sn, &cs);
        f32x2 o = {cs, sn};
        ROPE[idx] = o;
      }
    }
  }
}

#ifndef PH_MASK
#define PH_MASK 0xfff
#endif
DI void run_phase(const Params& p0, int ph, char* lds) {
  Params p = p0;
  asm volatile("" : "+s"(p.ws), "+s"(p.out));
  if (ph == 0) { if (PH_MASK & 0x200) prep_phase(p, lds); return; }
  if (ph == 1) { if (PH_MASK & 0x400) ln_phase(p, 1, nullptr, nullptr, 0, 0, 1024); return; }
  const int layer = (ph - 2) / 9, sub = (ph - 2) % 9;
  const bool even = (layer & 1) == 0;
  const int eo = layer >> 1;
  const u16* H = (const u16*)(p.ws + WS_H);
  if (!((PH_MASK >> sub) & 1)) return;
  switch (sub) {
    case 0:
      if (even) gemm_phase<EPI_PROJ>(p, layer, H, D, (const u16*)(p.ws + WS_WT_IN_E) + (size_t)eo * 3072 * 1024, 1024, 24, 0, lds);
      else gemm_phase<EPI_PROJ>(p, layer, H, D, (const u16*)(p.ws + WS_WT_IN_O) + (size_t)eo * 2432 * 1024, 1024, 19, 0, lds);
      break;
    case 1: mix_phase(p, layer, lds); break;
    case 2:
      for (int item = bid_(); item < 5120; item += gridDim.x) lin_scan_item(p, layer, item);
      break;
    case 3:
      for (int item = bid_(); item < 768; item += gridDim.x) lin_g3_item(p, layer, item, lds);
      break;
    case 4:
      gemm_phase<EPI_RESID>(p, layer, H, D, (const u16*)(p.ws + (even ? WS_WT_OUT_E : WS_WT_OUT_O)) + (size_t)eo * 1024 * 1024, 1024, 8, 2048, lds);
      break;
    case 5: ln_phase(p, 0, p.ln_g + (layer * 2) * 1024, p.ln_b + (layer * 2) * 1024, layer, 3072, 4096); break;
    case 6:
      gemm_phase<EPI_RELU2>(p, layer, H, D, (const u16*)(p.ws + WS_WT_FF1) + (size_t)layer * 4096 * 1024, 1024, 32, 0, lds);
      break;
    case 7:
      gemm_phase<EPI_RESID>(p, layer, (const u16*)(p.ws + WS_FFH), FF, (const u16*)(p.ws + WS_WT_FF2) + (size_t)layer * 4096 * 1024, 4096, 8, 5120, lds);
      break;
    case 8: ln_phase(p, 0, p.ln_g + (layer * 2 + 1) * 1024, p.ln_b + (layer * 2 + 1) * 1024, layer < 3 ? layer + 1 : -1, 0, 1024); break;
  }
}

__global__ void __launch_bounds__(256, 2) mega_kernel(Params p) {
  __shared__ __attribute__((aligned(16))) char lds[73728];
  cg::grid_group grid = cg::this_grid();
  for (int ph = p.ph_lo; ph < p.ph_hi; ++ph) {
    run_phase(p, ph, lds);
    if (ph + 1 < p.ph_hi) grid.sync();
  }
}

extern "C" void kernel_launch(void* const* d_in, const int* in_sizes, int n_in, void* d_out, int out_size, void* d_ws, size_t ws_size,
                              hipStream_t stream) {
  static int grid_blocks = 0;
  if (!grid_blocks) {
    int dev = 0, cus = 0, per_cu = 0;
    hipGetDevice(&dev);
    hipDeviceGetAttribute(&cus, hipDeviceAttributeMultiprocessorCount, dev);
    hipOccupancyMaxActiveBlocksPerMultiprocessor(&per_cu, mega_kernel, 256, 0);
    if (per_cu < 1) per_cu = 1;
    if (per_cu > 2) per_cu = 2;
    grid_blocks = cus * per_cu;
    if (ws_size < WS_END) fprintf(stderr, "kernel_launch: workspace too small: %zu < %zu\n", ws_size, (size_t)WS_END);
  }
  Params p{};
  const float** pp = (const float**)&p;
  for (int i = 0; i < 25; ++i) pp[i] = (const float*)d_in[i];
  p.out = (float*)d_out;
  p.ws = (char*)d_ws;
#if ONE_LAUNCH
  p.ph_lo = 0;
  p.ph_hi = NPH;
  void* args[] = {&p};
  hipError_t e = hipLaunchCooperativeKernel((void*)mega_kernel, dim3(grid_blocks), dim3(256), args, 0, stream);
  if (e != hipSuccess) fprintf(stderr, "cooperative launch failed: %s (grid %d)\n", hipGetErrorString(e), grid_blocks);
#else
  for (int ph = 0; ph < NPH; ++ph) {
    p.ph_lo = ph;
    p.ph_hi = ph + 1;
    hipLaunchKernelGGL(mega_kernel, dim3(grid_blocks), dim3(256), 0, stream, p);
  }
#endif
}
```

```cpp
#include <hip/hip_runtime.h>
#include <hip/hip_cooperative_groups.h>
#include <cstdio>
namespace cg = cooperative_groups;

typedef unsigned short u16;
typedef __bf16 b16x8 __attribute__((ext_vector_type(8)));
typedef __bf16 b16x2 __attribute__((ext_vector_type(2)));
typedef float f32x16 __attribute__((ext_vector_type(16)));
typedef float f32x4 __attribute__((ext_vector_type(4)));
typedef float f32x2 __attribute__((ext_vector_type(2)));
typedef unsigned u32x4 __attribute__((ext_vector_type(4)));
typedef unsigned u32x2 __attribute__((ext_vector_type(2)));

#define DI __device__ __forceinline__
#define MFMA(a, b, c) __builtin_amdgcn_mfma_f32_32x32x16_bf16((a), (b), (c), 0, 0, 0)

#ifndef ONE_LAUNCH
#define ONE_LAUNCH 1
#endif

constexpr int D = 1024, FF = 4096, MC = 4096, MTOK = 12288, LDP = 3072;
constexpr int NPH = 38;
constexpr float ALPHA = 1.681792830507429f;
constexpr float LOG2E = 1.4426950408889634f;

constexpr size_t WS_WT_IN_E = 0;
constexpr size_t WS_WT_OUT_E = WS_WT_IN_E + (size_t)2 * 3072 * 1024 * 2;
constexpr size_t WS_WT_IN_O = WS_WT_OUT_E + (size_t)2 * 1024 * 1024 * 2;
constexpr size_t WS_WT_OUT_O = WS_WT_IN_O + (size_t)2 * 2432 * 1024 * 2;
constexpr size_t WS_WT_FF1 = WS_WT_OUT_O + (size_t)2 * 1024 * 1024 * 2;
constexpr size_t WS_WT_FF2 = WS_WT_FF1 + (size_t)4 * 4096 * 1024 * 2;
constexpr size_t WS_CK_DIFF = WS_WT_FF2 + (size_t)4 * 4096 * 1024 * 2;
constexpr size_t WS_CVT_DIFF = WS_CK_DIFF + (size_t)4 * 2 * 4 * 2 * 256 * 64 * 2;
constexpr size_t WS_CK_SWA = WS_CVT_DIFF + (size_t)4 * 2 * 4 * 128 * 256 * 2;
constexpr size_t WS_CVT_SWA = WS_CK_SWA + (size_t)4 * 2 * 2 * 256 * 64 * 2;
constexpr size_t WS_MOD = WS_CVT_SWA + (size_t)4 * 2 * 2 * 64 * 256 * 2;
constexpr size_t WS_ROPE = WS_MOD + (size_t)4 * 5 * 6144 * 4;
constexpr size_t WS_H = WS_ROPE + (size_t)2048 * 32 * 2 * 4;
constexpr size_t WS_PROJ = WS_H + (size_t)MTOK * 1024 * 2;
constexpr size_t WS_PROJT = WS_PROJ + (size_t)MTOK * LDP * 2;
constexpr size_t WS_FFH = WS_PROJ;
constexpr size_t WS_LIN_U = WS_PROJT + (size_t)1280 * MTOK * 2;
constexpr size_t WS_LIN_S = WS_LIN_U + (size_t)1536 * 8192 * 4;
constexpr size_t WS_LIN_DEC = WS_LIN_S + (size_t)1536 * 8192 * 2;
constexpr size_t WS_BAR = WS_LIN_DEC + (size_t)1536 * 64 * 4;
constexpr size_t WS_END = WS_BAR + 16384;
static_assert(WS_PROJ + (size_t)MTOK * FF * 2 <= WS_LIN_U, "FFH alias overflow");

constexpr size_t OUT_X = 0;
constexpr size_t OUT_STATE_RET = 12582912;
constexpr size_t OUT_DIFF_K = 14680064;
constexpr size_t OUT_DIFF_V = 18874368;
constexpr size_t OUT_SWA_K = 23068672;
constexpr size_t OUT_SWA_V = 24117248;
constexpr size_t OUT_STATE_GLA = 25165824;

struct Params {
  const float *x_prompt, *x_sample, *c, *state_ret, *cache_diff_k, *cache_diff_v, *cache_swa_k, *cache_swa_v, *state_gla, *c_ctx,
      *w_mod, *b_mod, *ln_g, *ln_b, *w_in_even, *w_out_even, *ret_decay, *diff_lam, *w_in_odd, *w_out_odd, *swa_sink, *gla_w2,
      *gla_b, *w_ff1, *w_ff2;
  float* out;
  char* ws;
  int ph_lo, ph_hi;
};

DI int tid_() { int t = threadIdx.x; asm volatile("" : "+v"(t)); return t; }
DI int bid_() { int b = blockIdx.x; asm volatile("" : "+s"(b)); return b; }
DI unsigned pk2(float a, float b) {
  b16x2 v = __builtin_convertvector((f32x2){a, b}, b16x2);
  return __builtin_bit_cast(unsigned, v);
}
DI float bflo(unsigned u) { return __uint_as_float(u << 16); }
DI float bfhi(unsigned u) { return __uint_as_float(u & 0xffff0000u); }
DI float bf2f(u16 h) { return __uint_as_float(((unsigned)h) << 16); }
DI b16x8 as_b8(u32x4 v) { return __builtin_bit_cast(b16x8, v); }
DI float siluf(float x) { return x / (1.f + __expf(-x)); }
DI int mod_index(int row) { return row < MC ? 0 : 1 + ((row - MC) >> 11); }
DI u32x4 scale8(u32x4 raw, const float* f) {
  u32x4 o;
#pragma unroll
  for (int i = 0; i < 4; ++i) o[i] = pk2(bflo(raw[i]) * f[2 * i], bfhi(raw[i]) * f[2 * i + 1]);
  return o;
}

enum { EPI_PROJ = 0, EPI_RESID = 1, EPI_RELU2 = 2 };

DI int tr_row(bool even, int col) {
  if (even) {
    if (col >= 256 && col < 1024) return col - 256;
    if (col >= 2560 && col < 3072) return col - 2560 + 768;
    return -1;
  }
  if (col >= 640 && col < 768) return col - 640;
  if (col >= 1024 && col < 1792) return col - 1024 + 128;
  return -1;
}

template <int EPI>
DI void gemm_phase(const Params& p, int layer, const u16* __restrict__ A, int lda, const u16* __restrict__ Bt, int K, int tilesN,
                   int goff, char* lds) {
  u16* As = (u16*)lds;
  u16* Bs = As + 2 * 128 * 72;
  const int t = tid_(), l = t & 63, w = t >> 6, wm = w >> 1, wn = w & 1, c = l & 31, hf = l >> 5;
  const int lrow = t >> 3, lch = t & 7;
  const int nk = K >> 6;
  const int ntiles = (MTOK / 128) * tilesN;
  const bool even = (layer & 1) == 0;
  const int eo = layer >> 1;
  float* X = p.out + OUT_X;
  for (int tile = bid_(); tile < ntiles; tile += gridDim.x) {
    const int tm = tile / tilesN, tn = tile - tm * tilesN;
    const u16* Ag = A + (size_t)(tm * 128 + lrow) * lda + lch * 8;
    const u16* Bg = Bt + (size_t)(tn * 128 + lrow) * K + lch * 8;
    f32x16 acc[2][2];
#pragma unroll
    for (int i = 0; i < 2; ++i)
#pragma unroll
      for (int j = 0; j < 2; ++j)
#pragma unroll
        for (int r = 0; r < 16; ++r) acc[i][j][r] = 0.f;
    u32x4 ra[4], rb[4];
#pragma unroll
    for (int i = 0; i < 4; ++i) {
      ra[i] = *(const u32x4*)(Ag + (size_t)i * 32 * lda);
      rb[i] = *(const u32x4*)(Bg + (size_t)i * 32 * K);
    }
#pragma unroll
    for (int i = 0; i < 4; ++i) {
      *(u32x4*)(As + (lrow + 32 * i) * 72 + lch * 8) = ra[i];
      *(u32x4*)(Bs + (lrow + 32 * i) * 72 + lch * 8) = rb[i];
    }
    __syncthreads();
    for (int kt = 0; kt < nk; ++kt) {
      const int cur = kt & 1;
      if (kt + 1 < nk) {
#pragma unroll
        for (int i = 0; i < 4; ++i) {
          ra[i] = *(const u32x4*)(Ag + (size_t)i * 32 * lda + (kt + 1) * 64);
          rb[i] = *(const u32x4*)(Bg + (size_t)i * 32 * K + (kt + 1) * 64);
        }
      }
      const u16* ab = As + cur * 128 * 72 + (wm * 64 + c) * 72 + hf * 8;
      const u16* bb = Bs + cur * 128 * 72 + (wn * 64 + c) * 72 + hf * 8;
#pragma unroll
      for (int ks = 0; ks < 4; ++ks) {
        b16x8 a0 = *(const b16x8*)(ab + ks * 16);
        b16x8 a1 = *(const b16x8*)(ab + 32 * 72 + ks * 16);
        b16x8 b0 = *(const b16x8*)(bb + ks * 16);
        b16x8 b1 = *(const b16x8*)(bb + 32 * 72 + ks * 16);
        acc[0][0] = MFMA(a0, b0, acc[0][0]);
        acc[0][1] = MFMA(a0, b1, acc[0][1]);
        acc[1][0] = MFMA(a1, b0, acc[1][0]);
        acc[1][1] = MFMA(a1, b1, acc[1][1]);
      }
      if (kt + 1 < nk) {
        const int nx = cur ^ 1;
#pragma unroll
        for (int i = 0; i < 4; ++i) {
          *(u32x4*)(As + nx * 128 * 72 + (lrow + 32 * i) * 72 + lch * 8) = ra[i];
          *(u32x4*)(Bs + nx * 128 * 72 + (lrow + 32 * i) * 72 + lch * 8) = rb[i];
        }
      }
      __syncthreads();
    }
    const int rowt = tm * 128;
    if (EPI == EPI_RESID) {
      const float* gate = (const float*)(p.ws + WS_MOD) + (size_t)(layer * 5 + mod_index(rowt)) * 6144 + goff;
#pragma unroll
      for (int mt = 0; mt < 2; ++mt)
#pragma unroll
        for (int nt = 0; nt < 2; ++nt) {
          const int col = tn * 128 + wn * 64 + nt * 32 + c;
          const float g = gate[col];
#pragma unroll
          for (int r = 0; r < 16; ++r) {
            const int row = rowt + wm * 64 + mt * 32 + 8 * (r >> 2) + 4 * hf + (r & 3);
            float* px = X + (size_t)row * D + col;
            *px = ALPHA * (*px) + g * acc[mt][nt][r];
          }
        }
    } else if (EPI == EPI_RELU2) {
      u16* FFH = (u16*)(p.ws + WS_FFH);
#pragma unroll
      for (int mt = 0; mt < 2; ++mt)
#pragma unroll
        for (int nt = 0; nt < 2; ++nt) {
          const int col = tn * 128 + wn * 64 + nt * 32 + c;
#pragma unroll
          for (int r = 0; r < 16; ++r) {
            const int row = rowt + wm * 64 + mt * 32 + 8 * (r >> 2) + 4 * hf + (r & 3);
            float v = fmaxf(acc[mt][nt][r], 0.f);
            FFH[(size_t)row * FF + col] = (u16)(pk2(v * v, 0.f) & 0xffffu);
          }
        }
    } else {
      u16* PROJ = (u16*)(p.ws + WS_PROJ);
      u16* PROJT = (u16*)(p.ws + WS_PROJT);
      const f32x2* ROPE = (const f32x2*)(p.ws + WS_ROPE);
      const bool latent = rowt >= MC;
#pragma unroll
      for (int mt = 0; mt < 2; ++mt)
#pragma unroll
        for (int nt = 0; nt < 2; ++nt) {
          const int colb = tn * 128 + wn * 64 + nt * 32;
          const int col = colb + c;
          const int rowb = rowt + wm * 64 + mt * 32;
          float v[16];
#pragma unroll
          for (int r = 0; r < 16; ++r) v[r] = acc[mt][nt][r];
          const bool rope = latent && (even ? (colb >= 1536 && colb < 2560) : (colb < 640));
          if (rope) {
#pragma unroll
            for (int r = 0; r < 16; ++r) {
              const int row = rowb + 8 * (r >> 2) + 4 * hf + (r & 3);
              const int tpos = (row - MC) & 2047;
              const float partner = __shfl_xor(v[r], 16);
              const f32x2 cs = ROPE[tpos * 32 + nt * 16 + (c & 15)];
              v[r] = (c & 16) ? (v[r] * cs[0] + partner * cs[1]) : (v[r] * cs[0] - partner * cs[1]);
            }
          }
#pragma unroll
          for (int r = 0; r < 16; ++r) {
            const int row = rowb + 8 * (r >> 2) + 4 * hf + (r & 3);
            PROJ[(size_t)row * LDP + col] = (u16)(pk2(v[r], 0.f) & 0xffffu);
          }
          const int trb = tr_row(even, colb);
          if (trb >= 0) {
#pragma unroll
            for (int g = 0; g < 4; ++g) {
              u32x2 pv;
              pv[0] = pk2(v[4 * g], v[4 * g + 1]);
              pv[1] = pk2(v[4 * g + 2], v[4 * g + 3]);
              *(u32x2*)(PROJT + (size_t)(trb + c) * MTOK + rowb + 8 * g + 4 * hf) = pv;
            }
          }
          if (!latent) {
            float* dst = nullptr;
            int ldt = 64;
            const int b = rowb >> 8;
            if (even) {
              if (colb >= 2048 && colb < 2560) {
                const int j = col - 2048;
                dst = p.out + OUT_DIFF_K + ((size_t)((b * 2 + eo) * 8 + (j >> 6)) * 256) * 64 + (j & 63);
              } else if (colb >= 2560) {
                const int j = col - 2560;
                dst = p.out + OUT_DIFF_V + ((size_t)((b * 2 + eo) * 4 + (j >> 7)) * 256) * 128 + (j & 127);
                ldt = 128;
              }
            } else {
              if (colb >= 512 && colb < 640) {
                const int j = col - 512;
                dst = p.out + OUT_SWA_K + ((size_t)((b * 2 + eo) * 2 + (j >> 6)) * 256) * 64 + (j & 63);
              } else if (colb >= 640 && colb < 768) {
                const int j = col - 640;
                dst = p.out + OUT_SWA_V + ((size_t)((b * 2 + eo) * 2 + (j >> 6)) * 256) * 64 + (j & 63);
              }
            }
            if (dst) {
#pragma unroll
              for (int r = 0; r < 16; ++r) {
                const int tt = (rowb & 255) + 8 * (r >> 2) + 4 * hf + (r & 3);
                dst[(size_t)tt * ldt] = v[r];
              }
            }
          }
        }
    }
  }
}

struct KSeg {
  const u16* k0;
  const u16* k1;
  int ldk;
  const u16* vt;
  int ldv;
  int ntiles;
  int kpos0;
  int masked;
};

template <int DV, int NMAP>
DI void attn_gload(const KSeg& s, int j, int t, u32x4 (&rk)[NMAP * 2], u32x4 (&rv)[DV / 32]) {
#pragma unroll
  for (int i = 0; i < 2; ++i) {
    const int idx = t + 256 * i, row = idx >> 3, ch = idx & 7;
    rk[i] = *(const u32x4*)(s.k0 + (size_t)(j * 64 + row) * s.ldk + ch * 8);
    if (NMAP == 2) rk[2 + i] = *(const u32x4*)(s.k1 + (size_t)(j * 64 + row) * s.ldk + ch * 8);
  }
#pragma unroll
  for (int i = 0; i < DV / 32; ++i) {
    const int idx = t + 256 * i, row = idx >> 3, ch = idx & 7;
    rv[i] = *(const u32x4*)(s.vt + (size_t)row * s.ldv + j * 64 + ch * 8);
  }
}

template <int DV, bool DIFF>
DI void attn_item(const u16* q0, const u16* q1, int ldq, const KSeg& sA, const KSeg& sB, int qpos0, float sinkv, bool has_sink,
                  float lam, float outscale, u16* outp, char* lds) {
  constexpr int NMAP = DIFF ? 2 : 1;
  constexpr int NDT = DV / 32;
  u16* Ks = (u16*)lds;
  u16* Vs = Ks + NMAP * 64 * 72;
  float* Ex = (float*)lds;
  const int t = tid_(), l = t & 63, w = t >> 6, c = l & 31, hf = l >> 5;
  const int map = DIFF ? (w >> 1) : 0;
  const int qt = DIFF ? (w & 1) : w;
  const u16* qp = (map ? q1 : q0) + (size_t)(qt * 32 + c) * ldq + hf * 8;
  b16x8 qf[4];
#pragma unroll
  for (int ks = 0; ks < 4; ++ks) qf[ks] = *(const b16x8*)(qp + ks * 16);
  f32x16 O[NDT];
#pragma unroll
  for (int d = 0; d < NDT; ++d)
#pragma unroll
    for (int r = 0; r < 16; ++r) O[d][r] = 0.f;
  float m_run, l_run;
  if (has_sink) {
    m_run = sinkv * LOG2E;
    l_run = hf == 0 ? 1.f : 0.f;
  } else {
    m_run = -INFINITY;
    l_run = 0.f;
  }
  const float SC = 0.125f * LOG2E;
  const int ntot = sA.ntiles + sB.ntiles;
  u32x4 rk[NMAP * 2], rv[NDT];
  if (sA.ntiles > 0) attn_gload<DV, NMAP>(sA, 0, t, rk, rv);
  else attn_gload<DV, NMAP>(sB, 0, t, rk, rv);
  const int qpos = qpos0 + qt * 32 + c;
  for (int it = 0; it < ntot; ++it) {
    __syncthreads();
#pragma unroll
    for (int i = 0; i < 2; ++i) {
      const int idx = t + 256 * i, row = idx >> 3, ch = idx & 7;
      *(u32x4*)(Ks + row * 72 + ch * 8) = rk[i];
      if (NMAP == 2) *(u32x4*)(Ks + (64 + row) * 72 + ch * 8) = rk[2 + i];
    }
#pragma unroll
    for (int i = 0; i < NDT; ++i) {
      const int idx = t + 256 * i, row = idx >> 3, ch = idx & 7;
      *(u32x4*)(Vs + row * 72 + ch * 8) = rv[i];
    }
    __syncthreads();
    if (it + 1 < ntot) {
      const int nx = it + 1;
      if (nx < sA.ntiles) attn_gload<DV, NMAP>(sA, nx, t, rk, rv);
      else attn_gload<DV, NMAP>(sB, nx - sA.ntiles, t, rk, rv);
    }
    const bool inA = it < sA.ntiles;
    const int masked = inA ? sA.masked : sB.masked;
    const int kbase = inA ? (sA.kpos0 + it * 64) : (sB.kpos0 + (it - sA.ntiles) * 64);
    f32x16 s0, s1;
#pragma unroll
    for (int r = 0; r < 16; ++r) { s0[r] = 0.f; s1[r] = 0.f; }
    const u16* kb = Ks + map * 64 * 72 + c * 72 + hf * 8;
#pragma unroll
    for (int ks = 0; ks < 4; ++ks) {
      b16x8 a0 = *(const b16x8*)(kb + ks * 16);
      b16x8 a1 = *(const b16x8*)(kb + 32 * 72 + ks * 16);
      s0 = MFMA(a0, qf[ks], s0);
      s1 = MFMA(a1, qf[ks], s1);
    }
    float mx = -INFINITY;
#pragma unroll
    for (int r = 0; r < 16; ++r) {
      float v0 = s0[r] * SC, v1 = s1[r] * SC;
      if (!DIFF && masked) {
        const int d0 = qpos - (kbase + 8 * (r >> 2) + 4 * hf + (r & 3));
        const int d1 = d0 - 32;
        if (d0 > 128 || d0 < -128) v0 = -INFINITY;
        if (d1 > 128 || d1 < -128) v1 = -INFINITY;
      }
      s0[r] = v0;
      s1[r] = v1;
      mx = fmaxf(mx, fmaxf(v0, v1));
    }
    mx = fmaxf(mx, __shfl_xor(mx, 32));
    const float m_new = fmaxf(m_run, mx);
    const float alpha = __builtin_amdgcn_exp2f(m_run - m_new);
    m_run = m_new;
    float rs = 0.f;
#pragma unroll
    for (int r = 0; r < 16; ++r) {
      s0[r] = __builtin_amdgcn_exp2f(s0[r] - m_new);
      s1[r] = __builtin_amdgcn_exp2f(s1[r] - m_new);
      rs += s0[r] + s1[r];
    }
    l_run = l_run * alpha + rs;
#pragma unroll
    for (int d = 0; d < NDT; ++d)
#pragma unroll
      for (int r = 0; r < 16; ++r) O[d][r] *= alpha;
#pragma unroll
    for (int mt = 0; mt < 2; ++mt) {
#pragma unroll
      for (int u = 0; u < 2; ++u) {
        u32x4 pr;
#pragma unroll
        for (int i = 0; i < 4; ++i)
          pr[i] = mt == 0 ? pk2(s0[8 * u + 2 * i], s0[8 * u + 2 * i + 1]) : pk2(s1[8 * u + 2 * i], s1[8 * u + 2 * i + 1]);
        const b16x8 pb = as_b8(pr);
#pragma unroll
        for (int d = 0; d < NDT; ++d) {
          const u16* vb = Vs + (d * 32 + c) * 72 + mt * 32 + 16 * u + 4 * hf;
          const u32x2 lo = *(const u32x2*)vb;
          const u32x2 hi = *(const u32x2*)(vb + 8);
          u32x4 av;
          av[0] = lo[0]; av[1] = lo[1]; av[2] = hi[0]; av[3] = hi[1];
          O[d] = MFMA(as_b8(av), pb, O[d]);
        }
      }
    }
  }
  const float ltot = l_run + __shfl_xor(l_run, 32);
  const float inv = 1.f / ltot;
#pragma unroll
  for (int d = 0; d < NDT; ++d)
#pragma unroll
    for (int r = 0; r < 16; ++r) O[d][r] *= inv;
  if (!DIFF) {
#pragma unroll
    for (int d = 0; d < NDT; ++d)
#pragma unroll
      for (int g = 0; g < 4; ++g) {
        u32x2 pv;
        pv[0] = pk2(O[d][4 * g], O[d][4 * g + 1]);
        pv[1] = pk2(O[d][4 * g + 2], O[d][4 * g + 3]);
        *(u32x2*)(outp + (size_t)(qt * 32 + c) * D + d * 32 + 8 * g + 4 * hf) = pv;
      }
  } else {
    __syncthreads();
    if (map == 1) {
#pragma unroll
      for (int d = 0; d < NDT; ++d)
#pragma unroll
        for (int g = 0; g < 4; ++g) {
          f32x4 v = {O[d][4 * g], O[d][4 * g + 1], O[d][4 * g + 2], O[d][4 * g + 3]};
          *(f32x4*)(Ex + (qt * 32 + c) * (DV + 4) + d * 32 + 8 * g + 4 * hf) = v;
        }
    }
    __syncthreads();
    if (map == 0) {
      float sum = 0.f;
#pragma unroll
      for (int d = 0; d < NDT; ++d)
#pragma unroll
        for (int g = 0; g < 4; ++g) {
          const f32x4 v = *(const f32x4*)(Ex + (qt * 32 + c) * (DV + 4) + d * 32 + 8 * g + 4 * hf);
#pragma unroll
          for (int i = 0; i < 4; ++i) {
            O[d][4 * g + i] -= lam * v[i];
            sum += O[d][4 * g + i];
          }
        }
      sum += __shfl_xor(sum, 32);
      const float mean = sum * (1.f / DV);
      float sq = 0.f;
#pragma unroll
      for (int d = 0; d < NDT; ++d)
#pragma unroll
        for (int r = 0; r < 16; ++r) {
          const float dlt = O[d][r] - mean;
          sq += dlt * dlt;
        }
      sq += __shfl_xor(sq, 32);
      const float rstd = rsqrtf(sq * (1.f / DV) + 1e-5f) * outscale;
#pragma unroll
      for (int d = 0; d < NDT; ++d)
#pragma unroll
        for (int g = 0; g < 4; ++g) {
          u32x2 pv;
          pv[0] = pk2((O[d][4 * g] - mean) * rstd, (O[d][4 * g + 1] - mean) * rstd);
          pv[1] = pk2((O[d][4 * g + 2] - mean) * rstd, (O[d][4 * g + 3] - mean) * rstd);
          *(u32x2*)(outp + (size_t)(qt * 32 + c) * D + d * 32 + 8 * g + 4 * hf) = pv;
        }
    }
  }
}

struct LinCfg {
  int qcol, kcol, ktb, vtb, gcol, mixcol;
  float qscale, kscale;
  bool gla;
};
DI LinCfg lin_cfg(bool even) {
  LinCfg c;
  if (even) { c.qcol = 0; c.kcol = 256; c.ktb = 0; c.vtb = 256; c.gcol = 1024; c.mixcol = 0; c.qscale = 1.f; c.kscale = 0.125f; c.gla = false; }
  else { c.qcol = 768; c.kcol = 1024; c.ktb = 128; c.vtb = 384; c.gcol = 1792; c.mixcol = 512; c.qscale = 0.125f; c.kscale = 1.f; c.gla = true; }
  return c;
}

DI void fill_B(const Params& p, int layer, int tok0, int h, int dir, float* Bl, float* scr) {
  const int t = tid_();
  const bool even = (layer & 1) == 0;
  const int eo = layer >> 1;
  __syncthreads();
  if (even) {
    const float lg = -__expf(p.ret_decay[(eo * 2 + dir) * 4 + h]);
    for (int idx = t; idx < 4096; idx += 256) {
      const int j = idx >> 6, dd = idx & 63;
      Bl[j * 65 + dd] = (float)(dir ? (64 - j) : (j + 1)) * lg;
    }
    __syncthreads();
    return;
  }
  const u16* glr = (const u16*)(p.ws + WS_PROJ) + (size_t)tok0 * LDP + 2304 + dir * 16;
  for (int idx = t; idx < 1024; idx += 256) scr[idx] = bf2f(glr[(size_t)(idx >> 4) * LDP + (idx & 15)]);
  __syncthreads();
  {
    const int dd = t & 63, jq = t >> 6;
    const float* w2 = p.gla_w2 + (size_t)((eo * 2 + dir) * 16) * 256 + h * 64 + dd;
    float wv[16];
#pragma unroll
    for (int r = 0; r < 16; ++r) wv[r] = w2[r * 256];
    const float bb = p.gla_b[(eo * 2 + dir) * 256 + h * 64 + dd];
#pragma unroll 4
    for (int jj = 0; jj < 16; ++jj) {
      const int j = jq * 16 + jj;
      float z = bb;
#pragma unroll
      for (int r = 0; r < 16; ++r) z += scr[j * 16 + r] * wv[r];
      const float ls = fminf(z, 0.f) - log1pf(__expf(-fabsf(z)));
      Bl[j * 65 + dd] = ls * (1.f / 16.f);
    }
  }
  __syncthreads();
  if (t < 64) {
    float run = 0.f;
    if (!dir) {
      for (int j = 0; j < 64; ++j) { run += Bl[j * 65 + t]; Bl[j * 65 + t] = run; }
    } else {
      for (int j = 63; j >= 0; --j) { run += Bl[j * 65 + t]; Bl[j * 65 + t] = run; }
    }
  }
  __syncthreads();
}

DI void lin_g1_item(const Params& p, int layer, int item, char* lds) {
  float* Bl = (float*)lds;
  float* scr = Bl + 64 * 65;
  const int t = tid_(), l = t & 63, w = t >> 6, c = l & 31, hf = l >> 5;
  const int dir = item & 1, h = (item >> 1) & 3, cgi = item >> 3;
  const int tok0 = cgi * 64;
  const LinCfg cf = lin_cfg((layer & 1) == 0);
  fill_B(p, layer, tok0, h, dir, Bl, scr);
  const u16* PROJT = (const u16*)(p.ws + WS_PROJT);
  f32x16 acc[2];
#pragma unroll
  for (int i = 0; i < 2; ++i)
#pragma unroll
    for (int r = 0; r < 16; ++r) acc[i][r] = 0.f;
  const int brow = dir ? 0 : 63;
#pragma unroll
  for (int ks = 0; ks < 4; ++ks) {
    const int tk = ks * 16 + hf * 8;
    const b16x8 a = *(const b16x8*)(PROJT + (size_t)(cf.vtb + h * 128 + w * 32 + c) * MTOK + tok0 + tk);
#pragma unroll
    for (int nt = 0; nt < 2; ++nt) {
      const int dd = nt * 32 + c;
      const u32x4 raw = *(const u32x4*)(PROJT + (size_t)(cf.ktb + h * 64 + dd) * MTOK + tok0 + tk);
      const float btot = Bl[brow * 65 + dd];
      float f[8];
#pragma unroll
      for (int j = 0; j < 8; ++j) f[j] = __expf(btot - Bl[(tk + j) * 65 + dd]) * cf.kscale;
      acc[nt] = MFMA(a, as_b8(scale8(raw, f)), acc[nt]);
    }
  }
  float* U = (float*)(p.ws + WS_LIN_U) + (size_t)item * 8192;
#pragma unroll
  for (int nt = 0; nt < 2; ++nt)
#pragma unroll
    for (int r = 0; r < 16; ++r) U[(w * 32 + 8 * (r >> 2) + 4 * hf + (r & 3)) * 64 + nt * 32 + c] = acc[nt][r];
  if (t < 64) ((float*)(p.ws + WS_LIN_DEC))[(size_t)item * 64 + t] = __expf(Bl[brow * 65 + t]);
}

DI void lin_scan_item(const Params& p, int layer, int item) {
  const int t = tid_();
  const int unit = item >> 5, slab = item & 31;
  const int s = unit < 32 ? 16 + (unit >> 3) : ((unit - 32) >> 3);
  const int h = (unit >> 1) & 3, dir = unit & 1;
  const bool even = (layer & 1) == 0;
  const int eo = layer >> 1;
  const int elem = slab * 256 + t, dv = elem >> 6, dd = elem & 63;
  const int N = s < 16 ? 4 : 32;
  const int cg0 = s < 16 ? s * 4 : 64 + (s - 16) * 32;
  float S = 0.f;
  if (s >= 16) {
    const float* st = even ? p.state_ret : p.state_gla;
    S = st[((size_t)((((s - 16) * 2 + eo) * 2 + dir) * 4 + h) * 64 + dd) * 128 + dv];
  }
  const float* U = (const float*)(p.ws + WS_LIN_U);
  const float* DEC = (const float*)(p.ws + WS_LIN_DEC);
  u16* SP = (u16*)(p.ws + WS_LIN_S);
  for (int step = 0; step < N; ++step) {
    const int n = dir ? N - 1 - step : step;
    const size_t it = (size_t)((cg0 + n) * 4 + h) * 2 + dir;
    SP[it * 8192 + elem] = (u16)(pk2(S, 0.f) & 0xffffu);
    S = DEC[it * 64 + dd] * S + U[it * 8192 + elem];
  }
  if (s < 16) {
    float* o = p.out + (even ? OUT_STATE_RET : OUT_STATE_GLA);
    o[((size_t)(((s * 2 + eo) * 2 + dir) * 4 + h) * 64 + dd) * 128 + dv] = S;
  }
}

DI void lin_g3_item(const Params& p, int layer, int item, char* lds) {
  float* Bl = (float*)lds;
  float* scr = Bl + 64 * 65;
  float* red = scr + 1024;
  const int t = tid_(), l = t & 63, w = t >> 6, c = l & 31, hf = l >> 5;
  const int h = item & 3, cgi = item >> 2;
  const int tok0 = cgi * 64;
  const int tt = w & 1, dh = w >> 1;
  const LinCfg cf = lin_cfg((layer & 1) == 0);
  const u16* PROJ = (const u16*)(p.ws + WS_PROJ);
  const u16* PROJT = (const u16*)(p.ws + WS_PROJT);
  const u16* SP = (const u16*)(p.ws + WS_LIN_S);
  f32x16 O[2];
#pragma unroll
  for (int i = 0; i < 2; ++i)
#pragma unroll
    for (int r = 0; r < 16; ++r) O[i][r] = 0.f;
  const int tl = tt * 32 + c;
#pragma unroll 1
  for (int dir = 0; dir < 2; ++dir) {
    fill_B(p, layer, tok0, h, dir, Bl, scr);
    const size_t it = (size_t)(cgi * 4 + h) * 2 + dir;
    f32x16 P[2];
#pragma unroll
    for (int i = 0; i < 2; ++i)
#pragma unroll
      for (int r = 0; r < 16; ++r) P[i][r] = 0.f;
    u32x4 qs[4];
#pragma unroll
    for (int ks = 0; ks < 4; ++ks) {
      const int dd0 = ks * 16 + hf * 8;
      const u32x4 rawq = *(const u32x4*)(PROJ + (size_t)(tok0 + tl) * LDP + cf.qcol + h * 64 + dd0);
      float bm[8], f1[8], f2[8];
#pragma unroll
      for (int j = 0; j < 8; ++j) {
        bm[j] = Bl[32 * 65 + dd0 + j];
        const float bq = Bl[tl * 65 + dd0 + j];
        f1[j] = __expf(bq) * cf.qscale;
        f2[j] = __expf(bq - bm[j]) * cf.qscale;
      }
      qs[ks] = scale8(rawq, f1);
      const b16x8 qtl = as_b8(scale8(rawq, f2));
#pragma unroll
      for (int mt = 0; mt < 2; ++mt) {
        const int sI = mt * 32 + c;
        const u32x4 rawk = *(const u32x4*)(PROJ + (size_t)(tok0 + sI) * LDP + cf.kcol + h * 64 + dd0);
        float fk[8];
#pragma unroll
        for (int j = 0; j < 8; ++j) fk[j] = __expf(bm[j] - Bl[sI * 65 + dd0 + j]) * cf.kscale;
        P[mt] = MFMA(as_b8(scale8(rawk, fk)), qtl, P[mt]);
      }
    }
#pragma unroll
    for (int mt = 0; mt < 2; ++mt)
#pragma unroll
      for (int r = 0; r < 16; ++r) {
        const int sI = mt * 32 + 8 * (r >> 2) + 4 * hf + (r & 3);
        const bool valid = dir ? (sI >= tl) : (sI <= tl);
        P[mt][r] = valid ? P[mt][r] : 0.f;
      }
#pragma unroll
    for (int mt = 0; mt < 2; ++mt)
#pragma unroll
      for (int u = 0; u < 2; ++u) {
        u32x4 pr;
#pragma unroll
        for (int i = 0; i < 4; ++i) pr[i] = pk2(P[mt][8 * u + 2 * i], P[mt][8 * u + 2 * i + 1]);
        const b16x8 pb = as_b8(pr);
#pragma unroll
        for (int dt = 0; dt < 2; ++dt) {
          const u16* vp = PROJT + (size_t)(cf.vtb + h * 128 + dh * 64 + dt * 32 + c) * MTOK + tok0 + mt * 32 + 16 * u + 4 * hf;
          const u32x2 lo = *(const u32x2*)vp;
          const u32x2 hi = *(const u32x2*)(vp + 8);
          u32x4 av;
          av[0] = lo[0]; av[1] = lo[1]; av[2] = hi[0]; av[3] = hi[1];
          O[dt] = MFMA(as_b8(av), pb, O[dt]);
        }
      }
#pragma unroll
    for (int ks = 0; ks < 4; ++ks)
#pragma unroll
      for (int dt = 0; dt < 2; ++dt) {
        const b16x8 a = *(const b16x8*)(SP + it * 8192 + (size_t)(dh * 64 + dt * 32 + c) * 64 + ks * 16 + hf * 8);
        O[dt] = MFMA(a, as_b8(qs[ks]), O[dt]);
      }
  }
  float sum = 0.f;
#pragma unroll
  for (int dt = 0; dt < 2; ++dt)
#pragma unroll
    for (int r = 0; r < 16; ++r) sum += O[dt][r];
  sum += __shfl_xor(sum, 32);
  __syncthreads();
  if (hf == 0) red[w * 32 + c] = sum;
  __syncthreads();
  const float mean = (red[w * 32 + c] + red[(w ^ 2) * 32 + c]) * (1.f / 128.f);
  float sq = 0.f;
#pragma unroll
  for (int dt = 0; dt < 2; ++dt)
#pragma unroll
    for (int r = 0; r < 16; ++r) {
      const float d = O[dt][r] - mean;
      sq += d * d;
    }
  sq += __shfl_xor(sq, 32);
  if (hf == 0) red[128 + w * 32 + c] = sq;
  __syncthreads();
  const float rstd = rsqrtf((red[128 + w * 32 + c] + red[128 + (w ^ 2) * 32 + c]) * (1.f / 128.f) + 1e-5f);
  u16* MIX = (u16*)(p.ws + WS_H);
#pragma unroll
  for (int dt = 0; dt < 2; ++dt)
#pragma unroll
    for (int g = 0; g < 4; ++g) {
      const int dvi = dh * 64 + dt * 32 + 8 * g + 4 * hf;
      const u32x2 gr = *(const u32x2*)(PROJ + (size_t)(tok0 + tl) * LDP + cf.gcol + h * 128 + dvi);
      const float g0 = siluf(bflo(gr[0])), g1 = siluf(bfhi(gr[0])), g2 = siluf(bflo(gr[1])), g3 = siluf(bfhi(gr[1]));
      u32x2 pv;
      pv[0] = pk2((O[dt][4 * g] - mean) * rstd * g0, (O[dt][4 * g + 1] - mean) * rstd * g1);
      pv[1] = pk2((O[dt][4 * g + 2] - mean) * rstd * g2, (O[dt][4 * g + 3] - mean) * rstd * g3);
      *(u32x2*)(MIX + (size_t)(tok0 + tl) * D + cf.mixcol + h * 128 + dvi) = pv;
    }
}

DI void mix_phase(const Params& p, int layer, char* lds) {
  const bool even = (layer & 1) == 0;
  const int eo = layer >> 1;
  const u16* PROJ = (const u16*)(p.ws + WS_PROJ);
  const u16* PROJT = (const u16*)(p.ws + WS_PROJT);
  u16* MIX = (u16*)(p.ws + WS_H);
  float lam = 0.f, lam_init = 0.f;
  if (even) {
    lam_init = layer == 0 ? 0.2f : 0.47071301834358414f;
    const float* dl = p.diff_lam + eo * 256;
    float s1 = 0.f, s2 = 0.f;
    for (int i = 0; i < 64; ++i) { s1 += dl[i] * dl[64 + i]; s2 += dl[128 + i] * dl[192 + i]; }
    lam = __expf(s1) - __expf(s2) + lam_init;
  }
  const int nitems = 512 + 256 + 1536;
  if (even) {
    for (int item = bid_(); item < nitems; item += gridDim.x) {
      if (item >= 768) { lin_g1_item(p, layer, item - 768, lds); continue; }
      KSeg sA, sB;
      sB.k0 = sB.k1 = sB.vt = nullptr; sB.ldk = sB.ldv = 0; sB.ntiles = 0; sB.kpos0 = 0; sB.masked = 0;
      sA = sB;
      const bool lat = item < 512;
      const int i2 = lat ? item : item - 512;
      const int b = lat ? (i2 >> 7) : (i2 >> 4), h = lat ? ((i2 >> 5) & 3) : ((i2 >> 2) & 3), qb = lat ? (i2 & 31) : (i2 & 3);
      const size_t row0 = lat ? MC + (size_t)b * 2048 : (size_t)b * 256;
      KSeg own;
      own.k0 = PROJ + row0 * LDP + 2048 + h * 128; own.k1 = own.k0 + 64; own.ldk = LDP;
      own.vt = PROJT + (size_t)(768 + h * 128) * MTOK + row0; own.ldv = MTOK; own.ntiles = lat ? 32 : 4; own.kpos0 = 0; own.masked = 0;
      if (lat) {
        const u16* ck = (const u16*)(p.ws + WS_CK_DIFF) + (size_t)(((b * 2 + eo) * 4 + h) * 2) * 256 * 64;
        sA.k0 = ck; sA.k1 = ck + 256 * 64; sA.ldk = 64;
        sA.vt = (const u16*)(p.ws + WS_CVT_DIFF) + (size_t)((b * 2 + eo) * 4 + h) * 128 * 256; sA.ldv = 256; sA.ntiles = 4;
        sB = own;
      } else {
        sA = own;
      }
      const u16* q0 = PROJ + (row0 + qb * 64) * LDP + 1536 + h * 128;
      attn_item<128, true>(q0, q0 + 64, LDP, sA, sB, 0, 0.f, false, lam, 1.f - lam_init,
                           MIX + (row0 + qb * 64) * D + 512 + h * 128, lds);
    }
  } else {
    for (int item = bid_(); item < nitems; item += gridDim.x) {
      if (item >= 768) { lin_g1_item(p, layer, item - 768, lds); continue; }
      KSeg sA, sB;
      sB.k0 = sB.k1 = sB.vt = nullptr; sB.ldk = sB.ldv = 0; sB.ntiles = 0; sB.kpos0 = 0; sB.masked = 0;
      sA = sB;
      const bool lat = item < 512;
      const int i2 = lat ? item : item - 512;
      const int b = lat ? (i2 >> 7) : (i2 >> 4), h = lat ? ((i2 >> 4) & 7) : ((i2 >> 1) & 7), qb = lat ? (i2 & 15) : (i2 & 1);
      const int kv = h >> 2;
      const size_t row0 = lat ? MC + (size_t)b * 2048 : (size_t)b * 256;
      const int ks = lat ? max(0, qb * 128 - 128) : 0, ke = lat ? min(2048, qb * 128 + 256) : 256;
      KSeg own;
      own.k0 = own.k1 = PROJ + (row0 + ks) * LDP + 512 + kv * 64; own.ldk = LDP;
      own.vt = PROJT + (size_t)(kv * 64) * MTOK + row0 + ks; own.ldv = MTOK; own.ntiles = (ke - ks) >> 6; own.kpos0 = ks; own.masked = lat ? 1 : 0;
      if (lat) {
        sA.k0 = sA.k1 = (const u16*)(p.ws + WS_CK_SWA) + (size_t)((b * 2 + eo) * 2 + kv) * 256 * 64; sA.ldk = 64;
        sA.vt = (const u16*)(p.ws + WS_CVT_SWA) + (size_t)((b * 2 + eo) * 2 + kv) * 64 * 256; sA.ldv = 256; sA.ntiles = 4;
        sB = own;
      } else {
        sA = own;
      }
      const u16* q0 = PROJ + (row0 + qb * 128) * LDP + h * 64;
      attn_item<64, false>(q0, q0, LDP, sA, sB, qb * 128, p.swa_sink[eo * 8 + h], true, 0.f, 1.f,
                           MIX + (row0 + qb * 128) * D + h * 64, lds);
    }
  }
}

DI void ln_phase(const Params& p, int mode, const float* g, const float* b, int hlayer, int shoff, int scoff) {
  const int t = tid_(), l = t & 63, w = t >> 6;
  float* X = p.out + OUT_X;
  u16* H = (u16*)(p.ws + WS_H);
  const float* MOD = (const float*)(p.ws + WS_MOD);
  for (int row = bid_() * 4 + w; row < MTOK; row += gridDim.x * 4) {
    f32x4 v[4];
    if (mode == 1) {
      const float* src = row < MC ? p.x_prompt + (size_t)row * D : p.x_sample + (size_t)(row - MC) * D;
#pragma unroll
      for (int i = 0; i < 4; ++i) v[i] = *(const f32x4*)(src + i * 256 + l * 4);
    } else {
#pragma unroll
      for (int i = 0; i < 4; ++i) v[i] = *(const f32x4*)(X + (size_t)row * D + i * 256 + l * 4);
      float s = 0.f;
#pragma unroll
      for (int i = 0; i < 4; ++i) s += v[i][0] + v[i][1] + v[i][2] + v[i][3];
#pragma unroll
      for (int o = 32; o >= 1; o >>= 1) s += __shfl_xor(s, o);
      const float mean = s * (1.f / D);
      float q = 0.f;
#pragma unroll
      for (int i = 0; i < 4; ++i)
#pragma unroll
        for (int j = 0; j < 4; ++j) { const float d = v[i][j] - mean; q += d * d; }
#pragma unroll
      for (int o = 32; o >= 1; o >>= 1) q += __shfl_xor(q, o);
      const float rstd = rsqrtf(q * (1.f / D) + 1e-5f);
#pragma unroll
      for (int i = 0; i < 4; ++i) {
        const f32x4 gg = *(const f32x4*)(g + i * 256 + l * 4);
        const f32x4 bb = *(const f32x4*)(b + i * 256 + l * 4);
#pragma unroll
        for (int j = 0; j < 4; ++j) v[i][j] = (v[i][j] - mean) * rstd * gg[j] + bb[j];
      }
    }
#pragma unroll
    for (int i = 0; i < 4; ++i) *(f32x4*)(X + (size_t)row * D + i * 256 + l * 4) = v[i];
    if (hlayer >= 0) {
      const float* mp = MOD + (size_t)(hlayer * 5 + mod_index(row)) * 6144;
#pragma unroll
      for (int i = 0; i < 4; ++i) {
        const f32x4 sh = *(const f32x4*)(mp + shoff + i * 256 + l * 4);
        const f32x4 sc = *(const f32x4*)(mp + scoff + i * 256 + l * 4);
        u32x2 pv;
        pv[0] = pk2(v[i][0] * (1.f + sc[0]) + sh[0], v[i][1] * (1.f + sc[1]) + sh[1]);
        pv[1] = pk2(v[i][2] * (1.f + sc[2]) + sh[2], v[i][3] * (1.f + sc[3]) + sh[3]);
        *(u32x2*)(H + (size_t)row * D + i * 256 + l * 4) = pv;
      }
    }
  }
}

DI void prep_transpose_tile(const float* __restrict__ src, int K, int N, u16* __restrict__ dst, int tk, int tn, float* tile) {
  const int t = tid_();
  __syncthreads();
#pragma unroll
  for (int i = 0; i < 2; ++i) {
    const int row = (t >> 3) + 32 * i, c4 = (t & 7) * 4;
    const f32x4 v = *(const f32x4*)(src + (size_t)(tk * 64 + row) * N + tn * 32 + c4);
    tile[row * 33 + c4 + 0] = v[0];
    tile[row * 33 + c4 + 1] = v[1];
    tile[row * 33 + c4 + 2] = v[2];
    tile[row * 33 + c4 + 3] = v[3];
  }
  __syncthreads();
  const int n = t >> 3, kc = (t & 7) * 8;
  u32x4 o;
#pragma unroll
  for (int i = 0; i < 4; ++i) o[i] = pk2(tile[(kc + 2 * i) * 33 + n], tile[(kc + 2 * i + 1) * 33 + n]);
  *(u32x4*)(dst + (size_t)(tn * 32 + n) * K + tk * 64 + kc) = o;
}

DI void prep_mod_item(const Params& p, int item, char* lds) {
  float* sv = (float*)lds;
  float* red = sv + 5 * 1024;
  const int t = tid_();
  const int layer = item / 96, c0 = (item % 96) * 64;
  __syncthreads();
  for (int idx = t; idx < 5 * 1024; idx += 256) {
    const int m = idx >> 10, k = idx & 1023;
    const float x = m == 0 ? p.c_ctx[k] : p.c[(m - 1) * 1024 + k];
    sv[idx] = siluf(x);
  }
  __syncthreads();
  const int c4 = t & 15, kg = t >> 4;
  float acc[5][4];
#pragma unroll
  for (int m = 0; m < 5; ++m)
#pragma unroll
    for (int j = 0; j < 4; ++j) acc[m][j] = 0.f;
  const float* wp = p.w_mod + (size_t)layer * 1024 * 6144 + c0 + c4 * 4;
#pragma unroll 4
  for (int k = kg; k < 1024; k += 16) {
    const f32x4 wv = *(const f32x4*)(wp + (size_t)k * 6144);
#pragma unroll
    for (int m = 0; m < 5; ++m) {
      const float s = sv[m * 1024 + k];
#pragma unroll
      for (int j = 0; j < 4; ++j) acc[m][j] += s * wv[j];
    }
  }
#pragma unroll
  for (int m = 0; m < 5; ++m)
#pragma unroll
    for (int j = 0; j < 4; ++j) red[(kg * 5 + m) * 64 + c4 * 4 + j] = acc[m][j];
  __syncthreads();
  float* MOD = (float*)(p.ws + WS_MOD);
  for (int idx = t; idx < 320; idx += 256) {
    const int m = idx >> 6, cc = idx & 63;
    float s = p.b_mod[layer * 6144 + c0 + cc];
    for (int q = 0; q < 16; ++q) s += red[(q * 5 + m) * 64 + cc];
    MOD[(size_t)(layer * 5 + m) * 6144 + c0 + cc] = s;
  }
}

DI void prep_phase(const Params& p, char* lds) {
  const int t = tid_();
  constexpr int N_MOD = 384, N_TR = 24480, N_CK = 640, N_ROPE = 32;
  for (int item = bid_(); item < N_MOD + N_TR + N_CK + N_ROPE; item += gridDim.x) {
    if (item < N_MOD) {
      prep_mod_item(p, item, lds);
    } else if (item < N_MOD + N_TR) {
      int i = item - N_MOD;
      const float* src; u16* dst; int K, N, per; size_t sstride, dstride;
      if (i < 3072) { src = p.w_in_even; dst = (u16*)(p.ws + WS_WT_IN_E); K = 1024; N = 3072; per = 1536; sstride = (size_t)1024 * 3072; dstride = sstride; }
      else if (i < 4096) { i -= 3072; src = p.w_out_even; dst = (u16*)(p.ws + WS_WT_OUT_E); K = 1024; N = 1024; per = 512; sstride = (size_t)1024 * 1024; dstride = sstride; }
      else if (i < 6432) { i -= 4096; src = p.w_in_odd; dst = (u16*)(p.ws + WS_WT_IN_O); K = 1024; N = 2336; per = 1168; sstride = (size_t)1024 * 2336; dstride = (size_t)2432 * 1024; }
      else if (i < 7456) { i -= 6432; src = p.w_out_odd; dst = (u16*)(p.ws + WS_WT_OUT_O); K = 1024; N = 1024; per = 512; sstride = (size_t)1024 * 1024; dstride = sstride; }
      else if (i < 15648) { i -= 7456; src = p.w_ff1; dst = (u16*)(p.ws + WS_WT_FF1); K = 1024; N = 4096; per = 2048; sstride = (size_t)1024 * 4096; dstride = sstride; }
      else if (i < 23840) { i -= 15648; src = p.w_ff2; dst = (u16*)(p.ws + WS_WT_FF2); K = 4096; N = 1024; per = 2048; sstride = (size_t)1024 * 4096; dstride = sstride; }
      else if (i < 24352) { i -= 23840; src = p.cache_diff_v; dst = (u16*)(p.ws + WS_CVT_DIFF); K = 256; N = 128; per = 16; sstride = (size_t)256 * 128; dstride = sstride; }
      else { i -= 24352; src = p.cache_swa_v; dst = (u16*)(p.ws + WS_CVT_SWA); K = 256; N = 64; per = 8; sstride = (size_t)256 * 64; dstride = sstride; }
      const int mat = i / per, r = i - mat * per;
      const int ntn = N >> 5;
      const int tk = r / ntn, tn = r - tk * ntn;
      prep_transpose_tile(src + mat * sstride, K, N, dst + mat * dstride, tk, tn, (float*)lds);
    } else if (item < N_MOD + N_TR + N_CK) {
      const int i = item - N_MOD - N_TR;
      const float* src; u16* dst; int j;
      if (i < 512) { src = p.cache_diff_k; dst = (u16*)(p.ws + WS_CK_DIFF); j = i; }
      else { src = p.cache_swa_k; dst = (u16*)(p.ws + WS_CK_SWA); j = i - 512; }
      const size_t off = (size_t)j * 2048 + t * 8;
      const f32x4 a = *(const f32x4*)(src + off), b = *(const f32x4*)(src + off + 4);
      u32x4 o;
      o[0] = pk2(a[0], a[1]); o[1] = pk2(a[2], a[3]); o[2] = pk2(b[0], b[1]); o[3] = pk2(b[2], b[3]);
      *(u32x4*)(dst + off) = o;
    } else {
      const int i = item - N_MOD - N_TR - N_CK;
      f32x2* ROPE = (f32x2*)(p.ws + WS_ROPE);
      for (int q = 0; q < 8; ++q) {
        const int idx = i * 2048 + q * 256 + t;
        const int tp = idx >> 5, j = idx & 31;
        const float fr = powf(10000.f, -(float)(j & 15) * (1.f / 16.f));
        const float ang = (float)(j < 16 ? (tp >> 6) : (tp & 63)) * fr;
        float sn, cs;
        sincosf(ang, &sn, &cs);
        f32x2 o = {cs, sn};
        ROPE[idx] = o;
      }
    }
  }
}


#define XB_TMO      128
#define XB_XCNT(j)  (256  + 64 * (j))
#define XB_XSUB(j)  (1280 + 64 * (j))
#define XB_XGEN(j)  (2304 + 64 * (j))
#define XB_TOP      3328
#define XB_TOPGEN   3392
#define XCD_BAR_WORDS 3456
#define XB_SPIN_CAP (1u << 22)
#define LAS __attribute__((address_space(3)))
DI unsigned xb_ld(unsigned* p) { return __hip_atomic_load(p, __ATOMIC_RELAXED, __HIP_MEMORY_SCOPE_AGENT); }
DI unsigned xb_add(unsigned* p, unsigned v) { return __hip_atomic_fetch_add(p, v, __ATOMIC_RELAXED, __HIP_MEMORY_SCOPE_AGENT); }
DI unsigned xb_xcc_id() { return (unsigned)__builtin_amdgcn_s_getreg((3 << 11) | 20) & 0xFu; }
#define XB_SPIN(cond, bar) do { unsigned _sp = 0; while (cond) { __builtin_amdgcn_s_sleep(1); \
    if ((++_sp & 255u) == 0u) { if (xb_ld(&(bar)[XB_TMO])) break; if (_sp > XB_SPIN_CAP) { atomicAdd(&(bar)[XB_TMO], 1u); break; } } } } while (0)
struct XcdBarrier { unsigned* bar; unsigned x; volatile LAS unsigned* st; };
DI XcdBarrier xcd_barrier_post(unsigned* bar, volatile LAS unsigned* st) {
  XcdBarrier b; b.bar = bar; b.x = xb_xcc_id(); b.st = st;
  if (threadIdx.x == 0) (void)xb_add(&bar[XB_XCNT(b.x)], 1u);
  return b;
}
DI void xcd_barrier_complete(unsigned* bar, unsigned x, unsigned& nloc, unsigned& nx) {
  const unsigned G = gridDim.x * gridDim.y * gridDim.z;
  unsigned sum, cnt, mine, sp = 0u;
  for (;;) {
    sum = 0u; cnt = 0u; mine = 0u;
#pragma unroll
    for (unsigned j = 0; j < 16; ++j) { const unsigned c = xb_ld(&bar[XB_XCNT(j)]); sum += c; cnt += (c > 0u) ? 1u : 0u; mine = (j == x) ? c : mine; }
    if (sum == G) break;
    __builtin_amdgcn_s_sleep(1);
    if ((++sp & 255u) == 0u) { if (xb_ld(&bar[XB_TMO])) break; if (sp > XB_SPIN_CAP) { atomicAdd(&bar[XB_TMO], 1u); break; } }
  }
  nloc = mine > 0u ? mine : 1u; nx = cnt > 0u ? cnt : 1u;
}
DI void xcd_barrier(const XcdBarrier& b) {
  asm volatile("s_waitcnt vmcnt(0)" ::: "memory");
  __syncthreads();
  if (threadIdx.x == 0) {
    unsigned* bar = b.bar;
    __builtin_amdgcn_s_waitcnt(0);
    unsigned nloc = b.st[0], nx = b.st[1];
    if (nloc == 0u) { xcd_barrier_complete(bar, b.x, nloc, nx); b.st[0] = nloc; b.st[1] = nx; }
    const unsigned old = xb_add(&bar[XB_XSUB(b.x)], 1u);
    const unsigned gen = old / nloc;
    if (old + 1u == (gen + 1u) * nloc) {
      __builtin_amdgcn_fence(__ATOMIC_RELEASE, "agent");
      asm volatile("s_waitcnt vmcnt(0)" ::: "memory");
      const unsigned og = xb_add(&bar[XB_TOP], 1u);
      const unsigned tg = og / nx;
      if (og + 1u == (tg + 1u) * nx) xb_add(&bar[XB_TOPGEN], 1u);
      else XB_SPIN(xb_ld(&bar[XB_TOPGEN]) == tg, bar);
      __builtin_amdgcn_fence(__ATOMIC_ACQUIRE, "agent");
      xb_add(&bar[XB_XGEN(b.x)], 1u);
      asm volatile("s_waitcnt vmcnt(0)" ::: "memory");
    } else {
      XB_SPIN(xb_ld(&bar[XB_XGEN(b.x)]) == gen, bar);
      __builtin_amdgcn_fence(__ATOMIC_ACQUIRE, "agent");
      asm volatile("s_waitcnt vmcnt(0)" ::: "memory");
    }
  }
  __syncthreads();
}

#ifndef PH_MASK
#define PH_MASK 0xfff
#endif
DI void run_phase(const Params& p0, int ph, char* lds) {
  Params p = p0;
  asm volatile("" : "+s"(p.ws), "+s"(p.out));
  if (ph == 0) { if (PH_MASK & 0x200) prep_phase(p, lds); return; }
  if (ph == 1) { if (PH_MASK & 0x400) ln_phase(p, 1, nullptr, nullptr, 0, 0, 1024); return; }
  const int layer = (ph - 2) / 9, sub = (ph - 2) % 9;
  const bool even = (layer & 1) == 0;
  const int eo = layer >> 1;
  const u16* H = (const u16*)(p.ws + WS_H);
  if (!((PH_MASK >> sub) & 1)) return;
  switch (sub) {
    case 0:
      if (even) gemm_phase<EPI_PROJ>(p, layer, H, D, (const u16*)(p.ws + WS_WT_IN_E) + (size_t)eo * 3072 * 1024, 1024, 24, 0, lds);
      else gemm_phase<EPI_PROJ>(p, layer, H, D, (const u16*)(p.ws + WS_WT_IN_O) + (size_t)eo * 2432 * 1024, 1024, 19, 0, lds);
      break;
    case 1: mix_phase(p, layer, lds); break;
    case 2:
      for (int item = bid_(); item < 5120; item += gridDim.x) lin_scan_item(p, layer, item);
      break;
    case 3:
      for (int item = bid_(); item < 768; item += gridDim.x) lin_g3_item(p, layer, item, lds);
      break;
    case 4:
      gemm_phase<EPI_RESID>(p, layer, H, D, (const u16*)(p.ws + (even ? WS_WT_OUT_E : WS_WT_OUT_O)) + (size_t)eo * 1024 * 1024, 1024, 8, 2048, lds);
      break;
    case 5: ln_phase(p, 0, p.ln_g + (layer * 2) * 1024, p.ln_b + (layer * 2) * 1024, layer, 3072, 4096); break;
    case 6:
      gemm_phase<EPI_RELU2>(p, layer, H, D, (const u16*)(p.ws + WS_WT_FF1) + (size_t)layer * 4096 * 1024, 1024, 32, 0, lds);
      break;
    case 7:
      gemm_phase<EPI_RESID>(p, layer, (const u16*)(p.ws + WS_FFH), FF, (const u16*)(p.ws + WS_WT_FF2) + (size_t)layer * 4096 * 1024, 4096, 8, 5120, lds);
      break;
    case 8: ln_phase(p, 0, p.ln_g + (layer * 2 + 1) * 1024, p.ln_b + (layer * 2 + 1) * 1024, layer < 3 ? layer + 1 : -1, 0, 1024); break;
  }
}

__global__ void __launch_bounds__(256, 2) mega_kernel(Params p) {
  __shared__ __attribute__((aligned(16))) char lds[73728];
  __shared__ uint4 xb_words;
  cg::grid_group grid = cg::this_grid();
  if (threadIdx.x == 0) xb_words = make_uint4(0u, 0u, 0u, 0u);
  __syncthreads();
  XcdBarrier bar = xcd_barrier_post((unsigned*)(p.ws + WS_BAR), (volatile LAS unsigned*)&xb_words);
  for (int ph = p.ph_lo; ph < p.ph_hi; ++ph) {
    run_phase(p, ph, lds);
    if (ph + 1 < p.ph_hi) {
      if (p.ph_lo < 0) grid.sync();
      xcd_barrier(bar);
    }
  }
}

extern "C" void kernel_launch(void* const* d_in, const int* in_sizes, int n_in, void* d_out, int out_size, void* d_ws, size_t ws_size,
                              hipStream_t stream) {
  static int grid_blocks = 0;
  if (!grid_blocks) {
    int dev = 0, cus = 0, per_cu = 0;
    hipGetDevice(&dev);
    hipDeviceGetAttribute(&cus, hipDeviceAttributeMultiprocessorCount, dev);
    hipOccupancyMaxActiveBlocksPerMultiprocessor(&per_cu, mega_kernel, 256, 0);
    if (per_cu < 1) per_cu = 1;
    if (per_cu > 2) per_cu = 2;
    grid_blocks = cus * per_cu;
    if (ws_size < WS_END) fprintf(stderr, "kernel_launch: workspace too small: %zu < %zu\n", ws_size, (size_t)WS_END);
  }
  Params p{};
  const float** pp = (const float**)&p;
  for (int i = 0; i < 25; ++i) pp[i] = (const float*)d_in[i];
  p.out = (float*)d_out;
  p.ws = (char*)d_ws;
#if ONE_LAUNCH
  (void)hipMemsetAsync((char*)d_ws + WS_BAR, 0, 16384, stream);
  p.ph_lo = 0;
  p.ph_hi = NPH;
  void* args[] = {&p};
  hipError_t e = hipLaunchCooperativeKernel((void*)mega_kernel, dim3(grid_blocks), dim3(256), args, 0, stream);
  if (e != hipSuccess) fprintf(stderr, "cooperative launch failed: %s (grid %d)\n", hipGetErrorString(e), grid_blocks);
#else
  for (int ph = 0; ph < NPH; ++ph) {
    p.ph_lo = ph;
    p.ph_hi = ph + 1;
    hipLaunchKernelGGL(mega_kernel, dim3(grid_blocks), dim3(256), 0, stream, p);
  }
#endif
}
```

```cpp
#include <hip/hip_runtime.h>
#include <hip/hip_cooperative_groups.h>
#include <cstdio>
namespace cg = cooperative_groups;

typedef unsigned short u16;
typedef __bf16 b16x8 __attribute__((ext_vector_type(8)));
typedef __bf16 b16x2 __attribute__((ext_vector_type(2)));
typedef float f32x16 __attribute__((ext_vector_type(16)));
typedef float f32x4 __attribute__((ext_vector_type(4)));
typedef float f32x2 __attribute__((ext_vector_type(2)));
typedef unsigned u32x4 __attribute__((ext_vector_type(4)));
typedef unsigned u32x2 __attribute__((ext_vector_type(2)));

#define DI __device__ __forceinline__
#define MFMA(a, b, c) __builtin_amdgcn_mfma_f32_32x32x16_bf16((a), (b), (c), 0, 0, 0)

#ifndef ONE_LAUNCH
#define ONE_LAUNCH 1
#endif

constexpr int D = 1024, FF = 4096, MC = 4096, MTOK = 12288, LDP = 3072;
constexpr int NPH = 38;
constexpr float ALPHA = 1.681792830507429f;
constexpr float LOG2E = 1.4426950408889634f;

constexpr size_t WS_WT_IN_E = 0;
constexpr size_t WS_WT_OUT_E = WS_WT_IN_E + (size_t)2 * 3072 * 1024 * 2;
constexpr size_t WS_WT_IN_O = WS_WT_OUT_E + (size_t)2 * 1024 * 1024 * 2;
constexpr size_t WS_WT_OUT_O = WS_WT_IN_O + (size_t)2 * 2560 * 1024 * 2;
constexpr size_t WS_WT_FF1 = WS_WT_OUT_O + (size_t)2 * 1024 * 1024 * 2;
constexpr size_t WS_WT_FF2 = WS_WT_FF1 + (size_t)4 * 4096 * 1024 * 2;
constexpr size_t WS_CK_DIFF = WS_WT_FF2 + (size_t)4 * 4096 * 1024 * 2;
constexpr size_t WS_CVT_DIFF = WS_CK_DIFF + (size_t)4 * 2 * 4 * 2 * 256 * 64 * 2;
constexpr size_t WS_CK_SWA = WS_CVT_DIFF + (size_t)4 * 2 * 4 * 128 * 256 * 2;
constexpr size_t WS_CVT_SWA = WS_CK_SWA + (size_t)4 * 2 * 2 * 256 * 64 * 2;
constexpr size_t WS_MOD = WS_CVT_SWA + (size_t)4 * 2 * 2 * 64 * 256 * 2;
constexpr size_t WS_ROPE = WS_MOD + (size_t)4 * 5 * 6144 * 4;
constexpr size_t WS_H = WS_ROPE + (size_t)2048 * 32 * 2 * 4;
constexpr size_t WS_PROJ = WS_H + (size_t)MTOK * 1024 * 2;
constexpr size_t WS_PROJT = WS_PROJ + (size_t)MTOK * LDP * 2;
constexpr size_t WS_FFH = WS_PROJ;
constexpr size_t WS_LIN_U = WS_PROJT + (size_t)1280 * MTOK * 2;
constexpr size_t WS_LIN_S = WS_LIN_U + (size_t)1536 * 8192 * 4;
constexpr size_t WS_LIN_DEC = WS_LIN_S + (size_t)1536 * 8192 * 2;
constexpr size_t WS_BAR = WS_LIN_DEC + (size_t)1536 * 64 * 4;
constexpr size_t WS_END = WS_BAR + 16384;
static_assert(WS_PROJ + (size_t)MTOK * FF * 2 <= WS_LIN_U, "FFH alias overflow");

constexpr size_t OUT_X = 0;
constexpr size_t OUT_STATE_RET = 12582912;
constexpr size_t OUT_DIFF_K = 14680064;
constexpr size_t OUT_DIFF_V = 18874368;
constexpr size_t OUT_SWA_K = 23068672;
constexpr size_t OUT_SWA_V = 24117248;
constexpr size_t OUT_STATE_GLA = 25165824;

struct Params {
  const float *x_prompt, *x_sample, *c, *state_ret, *cache_diff_k, *cache_diff_v, *cache_swa_k, *cache_swa_v, *state_gla, *c_ctx,
      *w_mod, *b_mod, *ln_g, *ln_b, *w_in_even, *w_out_even, *ret_decay, *diff_lam, *w_in_odd, *w_out_odd, *swa_sink, *gla_w2,
      *gla_b, *w_ff1, *w_ff2;
  float* out;
  char* ws;
  int ph_lo, ph_hi;
};

DI int tid_() { int t = threadIdx.x & 255; asm volatile("" : "+v"(t)); return t; }
DI int vb_() { return __builtin_amdgcn_readfirstlane((int)(threadIdx.x >> 8)); }
DI int bid_() { int b = blockIdx.x * 2 + vb_(); asm volatile("" : "+s"(b)); return b; }
DI int gsz_() { return gridDim.x * 2; }
DI int rtid_() { int t = threadIdx.x; asm volatile("" : "+v"(t)); return t; }
DI int rbid_() { int b = blockIdx.x; asm volatile("" : "+s"(b)); return b; }
DI unsigned pk2(float a, float b) {
  b16x2 v = __builtin_convertvector((f32x2){a, b}, b16x2);
  return __builtin_bit_cast(unsigned, v);
}
DI float bflo(unsigned u) { return __uint_as_float(u << 16); }
DI float bfhi(unsigned u) { return __uint_as_float(u & 0xffff0000u); }
DI float bf2f(u16 h) { return __uint_as_float(((unsigned)h) << 16); }
DI b16x8 as_b8(u32x4 v) { return __builtin_bit_cast(b16x8, v); }
DI float siluf(float x) { return x / (1.f + __expf(-x)); }
DI int mod_index(int row) { return row < MC ? 0 : 1 + ((row - MC) >> 11); }
DI u32x4 scale8(u32x4 raw, const float* f) {
  u32x4 o;
#pragma unroll
  for (int i = 0; i < 4; ++i) o[i] = pk2(bflo(raw[i]) * f[2 * i], bfhi(raw[i]) * f[2 * i + 1]);
  return o;
}

enum { EPI_PROJ = 0, EPI_RESID = 1, EPI_RELU2 = 2 };

DI int tr_row(bool even, int col) {
  if (even) {
    if (col >= 256 && col < 1024) return col - 256;
    if (col >= 2560 && col < 3072) return col - 2560 + 768;
    return -1;
  }
  if (col >= 640 && col < 768) return col - 640;
  if (col >= 1024 && col < 1792) return col - 1024 + 128;
  return -1;
}

#define LAS __attribute__((address_space(3)))
typedef short s16x8 __attribute__((ext_vector_type(8)));
constexpr int G_BM = 256, G_BK = 64, G_HALF = 128, G_HTB = G_HALF * G_BK * 2;
DI int lds_byte(int r, int c) { const int st = (r >> 4) * 2 + (c >> 5), rr = r & 15, cc = c & 31, ob = rr * 64 + cc * 2; return st * 1024 + (ob ^ (((ob >> 9) & 1) << 5)); }
DI void stage_rc(int b, int& R, int& C) { const int st = b / 1024, sb = b % 1024, swz = sb ^ (((sb >> 9) & 1) << 5); R = (st >> 1) * 16 + swz / 64; C = (st & 1) * 32 + (swz % 64) / 2; }
DI int perm32(int rho) { const int n = rho >> 4, i = rho & 15; return 8 * (i >> 2) + 4 * n + (i & 3); }
struct Unit { int pm, pn; };
DI bool unit_next(int i, int c, int G, int nM, int nN, Unit& u) {
  const int nwg = nM * nN;
  const int L = i * G + c;
  if (L >= nwg) return false;
  const int wgid = (L & 7) * (nwg >> 3) + (L >> 3);
  const int nig = 8 * nN, gid = wgid / nig, fm = gid * 8, gsz = (nM - fm) < 8 ? (nM - fm) : 8;
  u.pm = fm + ((wgid % nig) % gsz);
  u.pn = (wgid % nig) / gsz;
  return true;
}

template <int EPI>
DI void gemm_epi(const Params& p, int layer, int goff, const f32x4 (&acc)[2][2][4][2], const Unit& u, int wr, int wc, int fr, int fq) {
  const int row0 = u.pm * G_BM + wr * 64 + fr;
  if (EPI == EPI_RESID) {
    float* X = p.out + OUT_X;
    const int col0 = u.pn * G_BM + wc * 32 + 4 * fq;
    const float* gate = (const float*)(p.ws + WS_MOD) + (size_t)(layer * 5 + mod_index(u.pm * G_BM)) * 6144 + goff + col0;
    f32x4 gv[2][2];
#pragma unroll
    for (int bj = 0; bj < 2; ++bj)
#pragma unroll
      for (int n = 0; n < 2; ++n) gv[bj][n] = *(const f32x4*)(gate + bj * G_HALF + n * 16);
#pragma unroll
    for (int ai = 0; ai < 2; ++ai)
#pragma unroll
      for (int m = 0; m < 4; ++m) {
        float* rowp = X + (size_t)(row0 + ai * G_HALF + m * 16) * D + col0;
#pragma unroll
        for (int bj = 0; bj < 2; ++bj)
#pragma unroll
          for (int n = 0; n < 2; ++n) {
            f32x4* px = (f32x4*)(rowp + bj * G_HALF + n * 16);
            const f32x4 x = *px;
            *px = ALPHA * x + gv[bj][n] * acc[ai][bj][m][n];
          }
      }
  } else if (EPI == EPI_RELU2) {
    u16* FFH = (u16*)(p.ws + WS_FFH);
    const int col0 = u.pn * G_BM + wc * 32 + 8 * fq;
#pragma unroll
    for (int ai = 0; ai < 2; ++ai)
#pragma unroll
      for (int m = 0; m < 4; ++m) {
        u16* rowp = FFH + (size_t)(row0 + ai * G_HALF + m * 16) * FF + col0;
#pragma unroll
        for (int bj = 0; bj < 2; ++bj) {
          f32x4 v0 = acc[ai][bj][m][0], v1 = acc[ai][bj][m][1];
#pragma unroll
          for (int j = 0; j < 4; ++j) { v0[j] = fmaxf(v0[j], 0.f); v0[j] *= v0[j]; v1[j] = fmaxf(v1[j], 0.f); v1[j] *= v1[j]; }
          u32x4 w;
          w[0] = pk2(v0[0], v0[1]); w[1] = pk2(v0[2], v0[3]); w[2] = pk2(v1[0], v1[1]); w[3] = pk2(v1[2], v1[3]);
          *(u32x4*)(rowp + bj * G_HALF) = w;
        }
      }
  } else {
    const bool even = (layer & 1) == 0;
    const int eo = layer >> 1;
    u16* PROJ = (u16*)(p.ws + WS_PROJ);
    u16* PROJT = (u16*)(p.ws + WS_PROJT);
    const f32x4* ROPE4 = (const f32x4*)(p.ws + WS_ROPE);
    const bool latent = u.pm * G_BM >= MC;
#pragma unroll
    for (int bj = 0; bj < 2; ++bj) {
      const int colg = u.pn * G_BM + bj * G_HALF + wc * 32;
      const int col0 = colg + 8 * fq;
      const bool rope = latent && (even ? (colg >= 1536 && colg < 2560) : (colg < 640));
      const int trb = tr_row(even, colg);
      const int seg = (colg >> 5) & 1;
      float* cdst = nullptr;
      int cld = 64;
      if (!latent) {
        const int b = (u.pm * G_BM) >> 8;
        if (even) {
          if (colg >= 2048 && colg < 2560) { const int jj = col0 - 2048; cdst = p.out + OUT_DIFF_K + ((size_t)((b * 2 + eo) * 8 + (jj >> 6)) * 256) * 64 + (jj & 63); }
          else if (colg >= 2560) { const int jj = col0 - 2560; cdst = p.out + OUT_DIFF_V + ((size_t)((b * 2 + eo) * 4 + (jj >> 7)) * 256) * 128 + (jj & 127); cld = 128; }
        } else {
          if (colg >= 512 && colg < 640) { const int jj = col0 - 512; cdst = p.out + OUT_SWA_K + ((size_t)((b * 2 + eo) * 2 + (jj >> 6)) * 256) * 64 + (jj & 63); }
          else if (colg >= 640 && colg < 768) { const int jj = col0 - 640; cdst = p.out + OUT_SWA_V + ((size_t)((b * 2 + eo) * 2 + (jj >> 6)) * 256) * 64 + (jj & 63); }
        }
      }
#pragma unroll
      for (int ai = 0; ai < 2; ++ai)
#pragma unroll
        for (int m = 0; m < 4; ++m) {
          const int row = row0 + ai * G_HALF + m * 16;
          float v[8];
#pragma unroll
          for (int j = 0; j < 4; ++j) { v[j] = acc[ai][bj][m][0][j]; v[4 + j] = acc[ai][bj][m][1][j]; }
          if (rope) {
            const int tpos = (row - MC) & 2047;
            const f32x4* cs = ROPE4 + (size_t)(tpos * 32 + seg * 16 + 8 * (fq & 1)) / 2;
#pragma unroll
            for (int q = 0; q < 4; ++q) {
              const f32x4 t4 = cs[q];
              const float pa = __shfl_xor(v[2 * q], 32), pb = __shfl_xor(v[2 * q + 1], 32);
              v[2 * q] = (fq & 2) ? (v[2 * q] * t4[0] + pa * t4[1]) : (v[2 * q] * t4[0] - pa * t4[1]);
              v[2 * q + 1] = (fq & 2) ? (v[2 * q + 1] * t4[2] + pb * t4[3]) : (v[2 * q + 1] * t4[2] - pb * t4[3]);
            }
          }
          u32x4 w;
          w[0] = pk2(v[0], v[1]); w[1] = pk2(v[2], v[3]); w[2] = pk2(v[4], v[5]); w[3] = pk2(v[6], v[7]);
          *(u32x4*)(PROJ + (size_t)row * LDP + col0) = w;
          if (trb >= 0) {
            u16* tp = PROJT + (size_t)(trb + 8 * fq) * MTOK + row;
#pragma unroll
            for (int j = 0; j < 4; ++j) {
              tp[(size_t)(2 * j) * MTOK] = (u16)(w[j] & 0xffffu);
              tp[(size_t)(2 * j + 1) * MTOK] = (u16)(w[j] >> 16);
            }
          }
          if (cdst) {
            float* d = cdst + (size_t)(row & 255) * cld;
            *(f32x4*)d = (f32x4){v[0], v[1], v[2], v[3]};
            *(f32x4*)(d + 4) = (f32x4){v[4], v[5], v[6], v[7]};
          }
        }
    }
  }
}

template <int EPI>
DI void gemm_phase(const Params& p, int layer, const u16* __restrict__ A, const u16* __restrict__ Bt, int K, int nN, int goff, char* lds_) {
  constexpr bool PERM = (EPI != EPI_RESID);
  LAS unsigned char* lds = (LAS unsigned char*)lds_;
  const int tid = rtid_(), wid = __builtin_amdgcn_readfirstlane(tid >> 6), lane = tid & 63, wr = wid >> 2, wc = wid & 3, fr = lane & 15, fq = lane >> 4;
  const int nt = K / G_BK;
  const int nM = MTOK / G_BM, G = gridDim.x, cidx = rbid_();
  unsigned voffA[2], voffB[2];
#pragma unroll
  for (int i = 0; i < 2; ++i) {
    int R, C;
    stage_rc(tid * 16 + i * 8192, R, C);
    const int Rb = PERM ? ((R & ~31) + perm32(R & 31)) : R;
    voffA[i] = (unsigned)(R * K + C) * 2u;
    voffB[i] = (unsigned)(Rb * K + C) * 2u;
  }
  const size_t kstep = (size_t)(G_BK * 2);
  const size_t hstep = (size_t)G_HALF * K * 2;
  const size_t tstep = 2 * hstep;
  const unsigned ldsw = (unsigned)wid * 1024u;
  const int aoff = lds_byte(wr * 64 + fr, fq * 8), boff = lds_byte(wc * 32 + fr, fq * 8);
#define PG8_SA(b, h) (((b) * 2 + (h)) * G_HTB)
#define PG8_SB(b, h) ((4 + (b) * 2 + (h)) * G_HTB)
#define PG8_STAGE(bufoff, gbase, voff) do { _Pragma("unroll") for (int _i = 0; _i < 2; ++_i) \
    __builtin_amdgcn_global_load_lds((const unsigned*)((const char*)(gbase) + (voff)[_i]), (LAS unsigned*)(lds + (bufoff) + ldsw + _i * 8192), 16, 0, 0); } while (0)
#define PG8_LDA(dst, b, h) do { _Pragma("unroll") for (int m = 0; m < 4; ++m) _Pragma("unroll") for (int k = 0; k < 2; ++k) dst[m][k] = *(const LAS s16x8*)(lds + PG8_SA(b, h) + aoff + m * 2048 + k * 1024); } while (0)
#define PG8_LDB(dst, b, h) do { _Pragma("unroll") for (int n = 0; n < 2; ++n) _Pragma("unroll") for (int k = 0; k < 2; ++k) dst[n][k] = *(const LAS s16x8*)(lds + PG8_SB(b, h) + boff + n * 2048 + k * 1024); } while (0)
#define PG8_MMA(ai, bj, At_, Bt_) do { __builtin_amdgcn_s_setprio(1); _Pragma("unroll") for (int m = 0; m < 4; ++m) _Pragma("unroll") for (int n = 0; n < 2; ++n) _Pragma("unroll") for (int k = 0; k < 2; ++k) \
    acc[ai][bj][m][n] = __builtin_amdgcn_mfma_f32_16x16x32_bf16(__builtin_bit_cast(b16x8, Bt_[n][k]), __builtin_bit_cast(b16x8, At_[m][k]), acc[ai][bj][m][n], 0, 0, 0); __builtin_amdgcn_s_setprio(0); } while (0)
#define PG8_WAIT_V(n) asm volatile("s_waitcnt vmcnt(" #n ")" ::: "memory")
#define PG8_WAIT_L(n) asm volatile("s_waitcnt lgkmcnt(" #n ")" ::: "memory")
#define PG8_BAR __builtin_amdgcn_s_barrier()
#define PG8_SCHED __builtin_amdgcn_sched_barrier(0)
  Unit cur, nxt;
  int ui = 0;
  if (!unit_next(0, cidx, G, nM, nN, cur)) return;
  f32x4 acc[2][2][4][2];
#pragma unroll
  for (int a = 0; a < 2; ++a)
#pragma unroll
    for (int b = 0; b < 2; ++b)
#pragma unroll
      for (int m = 0; m < 4; ++m)
#pragma unroll
        for (int n = 0; n < 2; ++n) acc[a][b][m][n] = (f32x4){0.f, 0.f, 0.f, 0.f};
  s16x8 At[4][2], B0[2][2], B1[2][2];
  const char* cA = (const char*)A + (size_t)cur.pm * tstep;
  const char* cB = (const char*)Bt + (size_t)cur.pn * tstep;
  PG8_STAGE(PG8_SB(0, 0), cB, voffB); PG8_STAGE(PG8_SA(0, 0), cA, voffA); PG8_STAGE(PG8_SB(0, 1), cB + hstep, voffB); PG8_STAGE(PG8_SA(0, 1), cA + hstep, voffA);
  if (wr == 1) PG8_BAR;
  PG8_WAIT_V(4); PG8_BAR;
  PG8_STAGE(PG8_SB(1, 0), cB + kstep, voffB); PG8_STAGE(PG8_SA(1, 0), cA + kstep, voffA); PG8_STAGE(PG8_SB(1, 1), cB + hstep + kstep, voffB);
  PG8_WAIT_V(6); PG8_BAR;
  for (;;) {
    const bool has_next = unit_next(ui + 1, cidx, G, nM, nN, nxt);
    const char* nA = has_next ? (const char*)A + (size_t)nxt.pm * tstep : cA;
    const char* nB = has_next ? (const char*)Bt + (size_t)nxt.pn * tstep : cB;
    for (int t = 0; t < nt; t += 2) {
      const bool last = (t == nt - 2);
      const char* a1 = cA + (size_t)(t + 1) * kstep;
      const char* a2 = last ? nA : cA + (size_t)(t + 2) * kstep;
      const char* b2 = last ? nB : cB + (size_t)(t + 2) * kstep;
      const char* a3 = a2 + kstep;
      const char* b3 = b2 + kstep;
      PG8_LDB(B0, 0, 0); PG8_SCHED; PG8_LDA(At, 0, 0); PG8_STAGE(PG8_SA(1, 1), a1 + hstep, voffA);
      PG8_WAIT_L(8); PG8_BAR; PG8_WAIT_L(0); PG8_MMA(0, 0, At, B0); PG8_BAR; PG8_SCHED;
      PG8_LDB(B1, 0, 1); PG8_STAGE(PG8_SB(0, 0), b2, voffB);
      PG8_BAR; PG8_WAIT_L(0); PG8_MMA(0, 1, At, B1); PG8_BAR;
      PG8_LDA(At, 0, 1); PG8_STAGE(PG8_SA(0, 0), a2, voffA);
      PG8_BAR; PG8_WAIT_L(0); PG8_MMA(1, 0, At, B0); PG8_BAR; PG8_SCHED;
      PG8_STAGE(PG8_SB(0, 1), b2 + hstep, voffB);
      PG8_WAIT_V(6); PG8_BAR; PG8_MMA(1, 1, At, B1); PG8_BAR;
      PG8_LDB(B0, 1, 0); PG8_SCHED; PG8_LDA(At, 1, 0); PG8_STAGE(PG8_SA(0, 1), a2 + hstep, voffA);
      PG8_WAIT_L(8); PG8_BAR; PG8_WAIT_L(0); PG8_MMA(0, 0, At, B0); PG8_BAR; PG8_SCHED;
      PG8_LDB(B1, 1, 1); PG8_STAGE(PG8_SB(1, 0), b3, voffB);
      PG8_BAR; PG8_WAIT_L(0); PG8_MMA(0, 1, At, B1); PG8_BAR;
      PG8_LDA(At, 1, 1); PG8_STAGE(PG8_SA(1, 0), a3, voffA);
      PG8_BAR; PG8_WAIT_L(0); PG8_MMA(1, 0, At, B0); PG8_BAR; PG8_SCHED;
      PG8_STAGE(PG8_SB(1, 1), b3 + hstep, voffB);
      PG8_WAIT_V(6); PG8_BAR; PG8_MMA(1, 1, At, B1); PG8_BAR;
    }
    gemm_epi<EPI>(p, layer, goff, acc, cur, wr, wc, fr, fq);
    if (!has_next) break;
#pragma unroll
    for (int a = 0; a < 2; ++a)
#pragma unroll
      for (int b = 0; b < 2; ++b)
#pragma unroll
        for (int m = 0; m < 4; ++m)
#pragma unroll
          for (int n = 0; n < 2; ++n) acc[a][b][m][n] = (f32x4){0.f, 0.f, 0.f, 0.f};
    cur = nxt; cA = nA; cB = nB; ++ui;
  }
  PG8_WAIT_V(0);
  if (wr == 0) PG8_BAR;
  PG8_BAR;
#undef PG8_SA
#undef PG8_SB
#undef PG8_STAGE
#undef PG8_LDA
#undef PG8_LDB
#undef PG8_MMA
#undef PG8_WAIT_V
#undef PG8_WAIT_L
#undef PG8_BAR
#undef PG8_SCHED
}

struct KSeg {
  const u16* k0;
  const u16* k1;
  int ldk;
  const u16* vt;
  int ldv;
  int ntiles;
  int kpos0;
  int masked;
};

template <int DV, int NMAP>
DI void attn_gload(const KSeg& s, int j, int t, u32x4 (&rk)[NMAP * 2], u32x4 (&rv)[DV / 32]) {
#pragma unroll
  for (int i = 0; i < 2; ++i) {
    const int idx = t + 256 * i, row = idx >> 3, ch = idx & 7;
    rk[i] = *(const u32x4*)(s.k0 + (size_t)(j * 64 + row) * s.ldk + ch * 8);
    if (NMAP == 2) rk[2 + i] = *(const u32x4*)(s.k1 + (size_t)(j * 64 + row) * s.ldk + ch * 8);
  }
#pragma unroll
  for (int i = 0; i < DV / 32; ++i) {
    const int idx = t + 256 * i, row = idx >> 3, ch = idx & 7;
    rv[i] = *(const u32x4*)(s.vt + (size_t)row * s.ldv + j * 64 + ch * 8);
  }
}

template <int DV, bool DIFF>
DI void attn_item(const u16* q0, const u16* q1, int ldq, const KSeg& sA, const KSeg& sB, int qpos0, float sinkv, bool has_sink,
                  float lam, float outscale, u16* outp, char* lds) {
  constexpr int NMAP = DIFF ? 2 : 1;
  constexpr int NDT = DV / 32;
  u16* Ks = (u16*)lds;
  u16* Vs = Ks + NMAP * 64 * 72;
  float* Ex = (float*)lds;
  const int t = tid_(), l = t & 63, w = t >> 6, c = l & 31, hf = l >> 5;
  const int map = DIFF ? (w >> 1) : 0;
  const int qt = DIFF ? (w & 1) : w;
  const u16* qp = (map ? q1 : q0) + (size_t)(qt * 32 + c) * ldq + hf * 8;
  b16x8 qf[4];
#pragma unroll
  for (int ks = 0; ks < 4; ++ks) qf[ks] = *(const b16x8*)(qp + ks * 16);
  f32x16 O[NDT];
#pragma unroll
  for (int d = 0; d < NDT; ++d)
#pragma unroll
    for (int r = 0; r < 16; ++r) O[d][r] = 0.f;
  float m_run, l_run;
  if (has_sink) {
    m_run = sinkv * LOG2E;
    l_run = hf == 0 ? 1.f : 0.f;
  } else {
    m_run = -INFINITY;
    l_run = 0.f;
  }
  const float SC = 0.125f * LOG2E;
  const int ntot = sA.ntiles + sB.ntiles;
  u32x4 rk[NMAP * 2], rv[NDT];
  if (sA.ntiles > 0) attn_gload<DV, NMAP>(sA, 0, t, rk, rv);
  else attn_gload<DV, NMAP>(sB, 0, t, rk, rv);
  const int qpos = qpos0 + qt * 32 + c;
  for (int it = 0; it < ntot; ++it) {
    __syncthreads();
#pragma unroll
    for (int i = 0; i < 2; ++i) {
      const int idx = t + 256 * i, row = idx >> 3, ch = idx & 7;
      *(u32x4*)(Ks + row * 72 + ch * 8) = rk[i];
      if (NMAP == 2) *(u32x4*)(Ks + (64 + row) * 72 + ch * 8) = rk[2 + i];
    }
#pragma unroll
    for (int i = 0; i < NDT; ++i) {
      const int idx = t + 256 * i, row = idx >> 3, ch = idx & 7;
      *(u32x4*)(Vs + row * 72 + ch * 8) = rv[i];
    }
    __syncthreads();
    if (it + 1 < ntot) {
      const int nx = it + 1;
      if (nx < sA.ntiles) attn_gload<DV, NMAP>(sA, nx, t, rk, rv);
      else attn_gload<DV, NMAP>(sB, nx - sA.ntiles, t, rk, rv);
    }
    const bool inA = it < sA.ntiles;
    const int masked = inA ? sA.masked : sB.masked;
    const int kbase = inA ? (sA.kpos0 + it * 64) : (sB.kpos0 + (it - sA.ntiles) * 64);
    f32x16 s0, s1;
#pragma unroll
    for (int r = 0; r < 16; ++r) { s0[r] = 0.f; s1[r] = 0.f; }
    const u16* kb = Ks + map * 64 * 72 + c * 72 + hf * 8;
#pragma unroll
    for (int ks = 0; ks < 4; ++ks) {
      b16x8 a0 = *(const b16x8*)(kb + ks * 16);
      b16x8 a1 = *(const b16x8*)(kb + 32 * 72 + ks * 16);
      s0 = MFMA(a0, qf[ks], s0);
      s1 = MFMA(a1, qf[ks], s1);
    }
    float mx = -INFINITY;
#pragma unroll
    for (int r = 0; r < 16; ++r) {
      float v0 = s0[r] * SC, v1 = s1[r] * SC;
      if (!DIFF && masked) {
        const int d0 = qpos - (kbase + 8 * (r >> 2) + 4 * hf + (r & 3));
        const int d1 = d0 - 32;
        if (d0 > 128 || d0 < -128) v0 = -INFINITY;
        if (d1 > 128 || d1 < -128) v1 = -INFINITY;
      }
      s0[r] = v0;
      s1[r] = v1;
      mx = fmaxf(mx, fmaxf(v0, v1));
    }
    mx = fmaxf(mx, __shfl_xor(mx, 32));
    const float m_new = fmaxf(m_run, mx);
    const float alpha = __builtin_amdgcn_exp2f(m_run - m_new);
    m_run = m_new;
    float rs = 0.f;
#pragma unroll
    for (int r = 0; r < 16; ++r) {
      s0[r] = __builtin_amdgcn_exp2f(s0[r] - m_new);
      s1[r] = __builtin_amdgcn_exp2f(s1[r] - m_new);
      rs += s0[r] + s1[r];
    }
    l_run = l_run * alpha + rs;
#pragma unroll
    for (int d = 0; d < NDT; ++d)
#pragma unroll
      for (int r = 0; r < 16; ++r) O[d][r] *= alpha;
#pragma unroll
    for (int mt = 0; mt < 2; ++mt) {
#pragma unroll
      for (int u = 0; u < 2; ++u) {
        u32x4 pr;
#pragma unroll
        for (int i = 0; i < 4; ++i)
          pr[i] = mt == 0 ? pk2(s0[8 * u + 2 * i], s0[8 * u + 2 * i + 1]) : pk2(s1[8 * u + 2 * i], s1[8 * u + 2 * i + 1]);
        const b16x8 pb = as_b8(pr);
#pragma unroll
        for (int d = 0; d < NDT; ++d) {
          const u16* vb = Vs + (d * 32 + c) * 72 + mt * 32 + 16 * u + 4 * hf;
          const u32x2 lo = *(const u32x2*)vb;
          const u32x2 hi = *(const u32x2*)(vb + 8);
          u32x4 av;
          av[0] = lo[0]; av[1] = lo[1]; av[2] = hi[0]; av[3] = hi[1];
          O[d] = MFMA(as_b8(av), pb, O[d]);
        }
      }
    }
  }
  const float ltot = l_run + __shfl_xor(l_run, 32);
  const float inv = 1.f / ltot;
#pragma unroll
  for (int d = 0; d < NDT; ++d)
#pragma unroll
    for (int r = 0; r < 16; ++r) O[d][r] *= inv;
  if (!DIFF) {
#pragma unroll
    for (int d = 0; d < NDT; ++d)
#pragma unroll
      for (int g = 0; g < 4; ++g) {
        u32x2 pv;
        pv[0] = pk2(O[d][4 * g], O[d][4 * g + 1]);
        pv[1] = pk2(O[d][4 * g + 2], O[d][4 * g + 3]);
        *(u32x2*)(outp + (size_t)(qt * 32 + c) * D + d * 32 + 8 * g + 4 * hf) = pv;
      }
  } else {
    __syncthreads();
    if (map == 1) {
#pragma unroll
      for (int d = 0; d < NDT; ++d)
#pragma unroll
        for (int g = 0; g < 4; ++g) {
          f32x4 v = {O[d][4 * g], O[d][4 * g + 1], O[d][4 * g + 2], O[d][4 * g + 3]};
          *(f32x4*)(Ex + (qt * 32 + c) * (DV + 4) + d * 32 + 8 * g + 4 * hf) = v;
        }
    }
    __syncthreads();
    if (map == 0) {
      float sum = 0.f;
#pragma unroll
      for (int d = 0; d < NDT; ++d)
#pragma unroll
        for (int g = 0; g < 4; ++g) {
          const f32x4 v = *(const f32x4*)(Ex + (qt * 32 + c) * (DV + 4) + d * 32 + 8 * g + 4 * hf);
#pragma unroll
          for (int i = 0; i < 4; ++i) {
            O[d][4 * g + i] -= lam * v[i];
            sum += O[d][4 * g + i];
          }
        }
      sum += __shfl_xor(sum, 32);
      const float mean = sum * (1.f / DV);
      float sq = 0.f;
#pragma unroll
      for (int d = 0; d < NDT; ++d)
#pragma unroll
        for (int r = 0; r < 16; ++r) {
          const float dlt = O[d][r] - mean;
          sq += dlt * dlt;
        }
      sq += __shfl_xor(sq, 32);
      const float rstd = rsqrtf(sq * (1.f / DV) + 1e-5f) * outscale;
#pragma unroll
      for (int d = 0; d < NDT; ++d)
#pragma unroll
        for (int g = 0; g < 4; ++g) {
          u32x2 pv;
          pv[0] = pk2((O[d][4 * g] - mean) * rstd, (O[d][4 * g + 1] - mean) * rstd);
          pv[1] = pk2((O[d][4 * g + 2] - mean) * rstd, (O[d][4 * g + 3] - mean) * rstd);
          *(u32x2*)(outp + (size_t)(qt * 32 + c) * D + d * 32 + 8 * g + 4 * hf) = pv;
        }
    }
  }
}

struct LinCfg {
  int qcol, kcol, ktb, vtb, gcol, mixcol;
  float qscale, kscale;
  bool gla;
};
DI LinCfg lin_cfg(bool even) {
  LinCfg c;
  if (even) { c.qcol = 0; c.kcol = 256; c.ktb = 0; c.vtb = 256; c.gcol = 1024; c.mixcol = 0; c.qscale = 1.f; c.kscale = 0.125f; c.gla = false; }
  else { c.qcol = 768; c.kcol = 1024; c.ktb = 128; c.vtb = 384; c.gcol = 1792; c.mixcol = 512; c.qscale = 0.125f; c.kscale = 1.f; c.gla = true; }
  return c;
}

DI void fill_B(const Params& p, int layer, int tok0, int h, int dir, float* Bl, float* scr) {
  const int t = tid_();
  const bool even = (layer & 1) == 0;
  const int eo = layer >> 1;
  __syncthreads();
  if (even) {
    const float lg = -__expf(p.ret_decay[(eo * 2 + dir) * 4 + h]);
    for (int idx = t; idx < 4096; idx += 256) {
      const int j = idx >> 6, dd = idx & 63;
      Bl[j * 65 + dd] = (float)(dir ? (64 - j) : (j + 1)) * lg;
    }
    __syncthreads();
    return;
  }
  const u16* glr = (const u16*)(p.ws + WS_PROJ) + (size_t)tok0 * LDP + 2304 + dir * 16;
  for (int idx = t; idx < 1024; idx += 256) scr[idx] = bf2f(glr[(size_t)(idx >> 4) * LDP + (idx & 15)]);
  __syncthreads();
  {
    const int dd = t & 63, jq = t >> 6;
    const float* w2 = p.gla_w2 + (size_t)((eo * 2 + dir) * 16) * 256 + h * 64 + dd;
    float wv[16];
#pragma unroll
    for (int r = 0; r < 16; ++r) wv[r] = w2[r * 256];
    const float bb = p.gla_b[(eo * 2 + dir) * 256 + h * 64 + dd];
#pragma unroll 4
    for (int jj = 0; jj < 16; ++jj) {
      const int j = jq * 16 + jj;
      float z = bb;
#pragma unroll
      for (int r = 0; r < 16; ++r) z += scr[j * 16 + r] * wv[r];
      const float ls = fminf(z, 0.f) - log1pf(__expf(-fabsf(z)));
      Bl[j * 65 + dd] = ls * (1.f / 16.f);
    }
  }
  __syncthreads();
  if (t < 64) {
    float run = 0.f;
    if (!dir) {
      for (int j = 0; j < 64; ++j) { run += Bl[j * 65 + t]; Bl[j * 65 + t] = run; }
    } else {
      for (int j = 63; j >= 0; --j) { run += Bl[j * 65 + t]; Bl[j * 65 + t] = run; }
    }
  }
  __syncthreads();
}

DI void lin_g1_item(const Params& p, int layer, int item, char* lds) {
  float* Bl = (float*)lds;
  float* scr = Bl + 64 * 65;
  const int t = tid_(), l = t & 63, w = t >> 6, c = l & 31, hf = l >> 5;
  const int dir = item & 1, h = (item >> 1) & 3, cgi = item >> 3;
  const int tok0 = cgi * 64;
  const LinCfg cf = lin_cfg((layer & 1) == 0);
  fill_B(p, layer, tok0, h, dir, Bl, scr);
  const u16* PROJT = (const u16*)(p.ws + WS_PROJT);
  f32x16 acc[2];
#pragma unroll
  for (int i = 0; i < 2; ++i)
#pragma unroll
    for (int r = 0; r < 16; ++r) acc[i][r] = 0.f;
  const int brow = dir ? 0 : 63;
#pragma unroll
  for (int ks = 0; ks < 4; ++ks) {
    const int tk = ks * 16 + hf * 8;
    const b16x8 a = *(const b16x8*)(PROJT + (size_t)(cf.vtb + h * 128 + w * 32 + c) * MTOK + tok0 + tk);
#pragma unroll
    for (int nt = 0; nt < 2; ++nt) {
      const int dd = nt * 32 + c;
      const u32x4 raw = *(const u32x4*)(PROJT + (size_t)(cf.ktb + h * 64 + dd) * MTOK + tok0 + tk);
      const float btot = Bl[brow * 65 + dd];
      float f[8];
#pragma unroll
      for (int j = 0; j < 8; ++j) f[j] = __expf(btot - Bl[(tk + j) * 65 + dd]) * cf.kscale;
      acc[nt] = MFMA(a, as_b8(scale8(raw, f)), acc[nt]);
    }
  }
  float* U = (float*)(p.ws + WS_LIN_U) + (size_t)item * 8192;
#pragma unroll
  for (int nt = 0; nt < 2; ++nt)
#pragma unroll
    for (int r = 0; r < 16; ++r) U[(w * 32 + 8 * (r >> 2) + 4 * hf + (r & 3)) * 64 + nt * 32 + c] = acc[nt][r];
  if (t < 64) ((float*)(p.ws + WS_LIN_DEC))[(size_t)item * 64 + t] = __expf(Bl[brow * 65 + t]);
}

DI void lin_scan_item(const Params& p, int layer, int item) {
  const int t = tid_();
  const int unit = item >> 5, slab = item & 31;
  const int s = unit < 32 ? 16 + (unit >> 3) : ((unit - 32) >> 3);
  const int h = (unit >> 1) & 3, dir = unit & 1;
  const bool even = (layer & 1) == 0;
  const int eo = layer >> 1;
  const int elem = slab * 256 + t, dv = elem >> 6, dd = elem & 63;
  const int N = s < 16 ? 4 : 32;
  const int cg0 = s < 16 ? s * 4 : 64 + (s - 16) * 32;
  float S = 0.f;
  if (s >= 16) {
    const float* st = even ? p.state_ret : p.state_gla;
    S = st[((size_t)((((s - 16) * 2 + eo) * 2 + dir) * 4 + h) * 64 + dd) * 128 + dv];
  }
  const float* U = (const float*)(p.ws + WS_LIN_U);
  const float* DEC = (const float*)(p.ws + WS_LIN_DEC);
  u16* SP = (u16*)(p.ws + WS_LIN_S);
  for (int step = 0; step < N; ++step) {
    const int n = dir ? N - 1 - step : step;
    const size_t it = (size_t)((cg0 + n) * 4 + h) * 2 + dir;
    SP[it * 8192 + elem] = (u16)(pk2(S, 0.f) & 0xffffu);
    S = DEC[it * 64 + dd] * S + U[it * 8192 + elem];
  }
  if (s < 16) {
    float* o = p.out + (even ? OUT_STATE_RET : OUT_STATE_GLA);
    o[((size_t)(((s * 2 + eo) * 2 + dir) * 4 + h) * 64 + dd) * 128 + dv] = S;
  }
}

DI void lin_g3_item(const Params& p, int layer, int item, char* lds) {
  float* Bl = (float*)lds;
  float* scr = Bl + 64 * 65;
  float* red = scr + 1024;
  const int t = tid_(), l = t & 63, w = t >> 6, c = l & 31, hf = l >> 5;
  const int h = item & 3, cgi = item >> 2;
  const int tok0 = cgi * 64;
  const int tt = w & 1, dh = w >> 1;
  const LinCfg cf = lin_cfg((layer & 1) == 0);
  const u16* PROJ = (const u16*)(p.ws + WS_PROJ);
  const u16* PROJT = (const u16*)(p.ws + WS_PROJT);
  const u16* SP = (const u16*)(p.ws + WS_LIN_S);
  f32x16 O[2];
#pragma unroll
  for (int i = 0; i < 2; ++i)
#pragma unroll
    for (int r = 0; r < 16; ++r) O[i][r] = 0.f;
  const int tl = tt * 32 + c;
#pragma unroll 1
  for (int dir = 0; dir < 2; ++dir) {
    fill_B(p, layer, tok0, h, dir, Bl, scr);
    const size_t it = (size_t)(cgi * 4 + h) * 2 + dir;
    f32x16 P[2];
#pragma unroll
    for (int i = 0; i < 2; ++i)
#pragma unroll
      for (int r = 0; r < 16; ++r) P[i][r] = 0.f;
    u32x4 qs[4];
#pragma unroll
    for (int ks = 0; ks < 4; ++ks) {
      const int dd0 = ks * 16 + hf * 8;
      const u32x4 rawq = *(const u32x4*)(PROJ + (size_t)(tok0 + tl) * LDP + cf.qcol + h * 64 + dd0);
      float bm[8], f1[8], f2[8];
#pragma unroll
      for (int j = 0; j < 8; ++j) {
        bm[j] = Bl[32 * 65 + dd0 + j];
        const float bq = Bl[tl * 65 + dd0 + j];
        f1[j] = __expf(bq) * cf.qscale;
        f2[j] = __expf(bq - bm[j]) * cf.qscale;
      }
      qs[ks] = scale8(rawq, f1);
      const b16x8 qtl = as_b8(scale8(rawq, f2));
#pragma unroll
      for (int mt = 0; mt < 2; ++mt) {
        const int sI = mt * 32 + c;
        const u32x4 rawk = *(const u32x4*)(PROJ + (size_t)(tok0 + sI) * LDP + cf.kcol + h * 64 + dd0);
        float fk[8];
#pragma unroll
        for (int j = 0; j < 8; ++j) fk[j] = __expf(bm[j] - Bl[sI * 65 + dd0 + j]) * cf.kscale;
        P[mt] = MFMA(as_b8(scale8(rawk, fk)), qtl, P[mt]);
      }
    }
#pragma unroll
    for (int mt = 0; mt < 2; ++mt)
#pragma unroll
      for (int r = 0; r < 16; ++r) {
        const int sI = mt * 32 + 8 * (r >> 2) + 4 * hf + (r & 3);
        const bool valid = dir ? (sI >= tl) : (sI <= tl);
        P[mt][r] = valid ? P[mt][r] : 0.f;
      }
#pragma unroll
    for (int mt = 0; mt < 2; ++mt)
#pragma unroll
      for (int u = 0; u < 2; ++u) {
        u32x4 pr;
#pragma unroll
        for (int i = 0; i < 4; ++i) pr[i] = pk2(P[mt][8 * u + 2 * i], P[mt][8 * u + 2 * i + 1]);
        const b16x8 pb = as_b8(pr);
#pragma unroll
        for (int dt = 0; dt < 2; ++dt) {
          const u16* vp = PROJT + (size_t)(cf.vtb + h * 128 + dh * 64 + dt * 32 + c) * MTOK + tok0 + mt * 32 + 16 * u + 4 * hf;
          const u32x2 lo = *(const u32x2*)vp;
          const u32x2 hi = *(const u32x2*)(vp + 8);
          u32x4 av;
          av[0] = lo[0]; av[1] = lo[1]; av[2] = hi[0]; av[3] = hi[1];
          O[dt] = MFMA(as_b8(av), pb, O[dt]);
        }
      }
#pragma unroll
    for (int ks = 0; ks < 4; ++ks)
#pragma unroll
      for (int dt = 0; dt < 2; ++dt) {
        const b16x8 a = *(const b16x8*)(SP + it * 8192 + (size_t)(dh * 64 + dt * 32 + c) * 64 + ks * 16 + hf * 8);
        O[dt] = MFMA(a, as_b8(qs[ks]), O[dt]);
      }
  }
  float sum = 0.f;
#pragma unroll
  for (int dt = 0; dt < 2; ++dt)
#pragma unroll
    for (int r = 0; r < 16; ++r) sum += O[dt][r];
  sum += __shfl_xor(sum, 32);
  __syncthreads();
  if (hf == 0) red[w * 32 + c] = sum;
  __syncthreads();
  const float mean = (red[w * 32 + c] + red[(w ^ 2) * 32 + c]) * (1.f / 128.f);
  float sq = 0.f;
#pragma unroll
  for (int dt = 0; dt < 2; ++dt)
#pragma unroll
    for (int r = 0; r < 16; ++r) {
      const float d = O[dt][r] - mean;
      sq += d * d;
    }
  sq += __shfl_xor(sq, 32);
  if (hf == 0) red[128 + w * 32 + c] = sq;
  __syncthreads();
  const float rstd = rsqrtf((red[128 + w * 32 + c] + red[128 + (w ^ 2) * 32 + c]) * (1.f / 128.f) + 1e-5f);
  u16* MIX = (u16*)(p.ws + WS_H);
#pragma unroll
  for (int dt = 0; dt < 2; ++dt)
#pragma unroll
    for (int g = 0; g < 4; ++g) {
      const int dvi = dh * 64 + dt * 32 + 8 * g + 4 * hf;
      const u32x2 gr = *(const u32x2*)(PROJ + (size_t)(tok0 + tl) * LDP + cf.gcol + h * 128 + dvi);
      const float g0 = siluf(bflo(gr[0])), g1 = siluf(bfhi(gr[0])), g2 = siluf(bflo(gr[1])), g3 = siluf(bfhi(gr[1]));
      u32x2 pv;
      pv[0] = pk2((O[dt][4 * g] - mean) * rstd * g0, (O[dt][4 * g + 1] - mean) * rstd * g1);
      pv[1] = pk2((O[dt][4 * g + 2] - mean) * rstd * g2, (O[dt][4 * g + 3] - mean) * rstd * g3);
      *(u32x2*)(MIX + (size_t)(tok0 + tl) * D + cf.mixcol + h * 128 + dvi) = pv;
    }
}

DI void mix_phase(const Params& p, int layer, char* lds) {
  const bool even = (layer & 1) == 0;
  const int eo = layer >> 1;
  const u16* PROJ = (const u16*)(p.ws + WS_PROJ);
  const u16* PROJT = (const u16*)(p.ws + WS_PROJT);
  u16* MIX = (u16*)(p.ws + WS_H);
  float lam = 0.f, lam_init = 0.f;
  if (even) {
    lam_init = layer == 0 ? 0.2f : 0.47071301834358414f;
    const float* dl = p.diff_lam + eo * 256;
    float s1 = 0.f, s2 = 0.f;
    for (int i = 0; i < 64; ++i) { s1 += dl[i] * dl[64 + i]; s2 += dl[128 + i] * dl[192 + i]; }
    lam = __expf(s1) - __expf(s2) + lam_init;
  }
  const int nitems = 512 + 256 + 1536;
  if (even) {
    for (int item = bid_(); item < nitems; item += gsz_()) {
      if (item >= 768) { lin_g1_item(p, layer, item - 768, lds); continue; }
      KSeg sA, sB;
      sB.k0 = sB.k1 = sB.vt = nullptr; sB.ldk = sB.ldv = 0; sB.ntiles = 0; sB.kpos0 = 0; sB.masked = 0;
      sA = sB;
      const bool lat = item < 512;
      const int i2 = lat ? item : item - 512;
      const int b = lat ? (i2 >> 7) : (i2 >> 4), h = lat ? ((i2 >> 5) & 3) : ((i2 >> 2) & 3), qb = lat ? (i2 & 31) : (i2 & 3);
      const size_t row0 = lat ? MC + (size_t)b * 2048 : (size_t)b * 256;
      KSeg own;
      own.k0 = PROJ + row0 * LDP + 2048 + h * 128; own.k1 = own.k0 + 64; own.ldk = LDP;
      own.vt = PROJT + (size_t)(768 + h * 128) * MTOK + row0; own.ldv = MTOK; own.ntiles = lat ? 32 : 4; own.kpos0 = 0; own.masked = 0;
      if (lat) {
        const u16* ck = (const u16*)(p.ws + WS_CK_DIFF) + (size_t)(((b * 2 + eo) * 4 + h) * 2) * 256 * 64;
        sA.k0 = ck; sA.k1 = ck + 256 * 64; sA.ldk = 64;
        sA.vt = (const u16*)(p.ws + WS_CVT_DIFF) + (size_t)((b * 2 + eo) * 4 + h) * 128 * 256; sA.ldv = 256; sA.ntiles = 4;
        sB = own;
      } else {
        sA = own;
      }
      const u16* q0 = PROJ + (row0 + qb * 64) * LDP + 1536 + h * 128;
      attn_item<128, true>(q0, q0 + 64, LDP, sA, sB, 0, 0.f, false, lam, 1.f - lam_init,
                           MIX + (row0 + qb * 64) * D + 512 + h * 128, lds);
    }
  } else {
    for (int item = bid_(); item < nitems; item += gsz_()) {
      if (item >= 768) { lin_g1_item(p, layer, item - 768, lds); continue; }
      KSeg sA, sB;
      sB.k0 = sB.k1 = sB.vt = nullptr; sB.ldk = sB.ldv = 0; sB.ntiles = 0; sB.kpos0 = 0; sB.masked = 0;
      sA = sB;
      const bool lat = item < 512;
      const int i2 = lat ? item : item - 512;
      const int b = lat ? (i2 >> 7) : (i2 >> 4), h = lat ? ((i2 >> 4) & 7) : ((i2 >> 1) & 7), qb = lat ? (i2 & 15) : (i2 & 1);
      const int kv = h >> 2;
      const size_t row0 = lat ? MC + (size_t)b * 2048 : (size_t)b * 256;
      const int ks = lat ? min(max(0, qb * 128 - 128), 2048 - 384) : 0, ke = lat ? ks + 384 : 256;
      KSeg own;
      own.k0 = own.k1 = PROJ + (row0 + ks) * LDP + 512 + kv * 64; own.ldk = LDP;
      own.vt = PROJT + (size_t)(kv * 64) * MTOK + row0 + ks; own.ldv = MTOK; own.ntiles = (ke - ks) >> 6; own.kpos0 = ks; own.masked = lat ? 1 : 0;
      if (lat) {
        sA.k0 = sA.k1 = (const u16*)(p.ws + WS_CK_SWA) + (size_t)((b * 2 + eo) * 2 + kv) * 256 * 64; sA.ldk = 64;
        sA.vt = (const u16*)(p.ws + WS_CVT_SWA) + (size_t)((b * 2 + eo) * 2 + kv) * 64 * 256; sA.ldv = 256; sA.ntiles = 4;
        sB = own;
      } else {
        sA = own;
      }
      const u16* q0 = PROJ + (row0 + qb * 128) * LDP + h * 64;
      attn_item<64, false>(q0, q0, LDP, sA, sB, qb * 128, p.swa_sink[eo * 8 + h], true, 0.f, 1.f,
                           MIX + (row0 + qb * 128) * D + h * 64, lds);
    }
  }
}

DI void ln_phase(const Params& p, int mode, const float* g, const float* b, int hlayer, int shoff, int scoff) {
  const int t = tid_(), l = t & 63, w = t >> 6;
  float* X = p.out + OUT_X;
  u16* H = (u16*)(p.ws + WS_H);
  const float* MOD = (const float*)(p.ws + WS_MOD);
  for (int row = bid_() * 4 + w; row < MTOK; row += gsz_() * 4) {
    f32x4 v[4];
    if (mode == 1) {
      const float* src = row < MC ? p.x_prompt + (size_t)row * D : p.x_sample + (size_t)(row - MC) * D;
#pragma unroll
      for (int i = 0; i < 4; ++i) v[i] = *(const f32x4*)(src + i * 256 + l * 4);
    } else {
#pragma unroll
      for (int i = 0; i < 4; ++i) v[i] = *(const f32x4*)(X + (size_t)row * D + i * 256 + l * 4);
      float s = 0.f;
#pragma unroll
      for (int i = 0; i < 4; ++i) s += v[i][0] + v[i][1] + v[i][2] + v[i][3];
#pragma unroll
      for (int o = 32; o >= 1; o >>= 1) s += __shfl_xor(s, o);
      const float mean = s * (1.f / D);
      float q = 0.f;
#pragma unroll
      for (int i = 0; i < 4; ++i)
#pragma unroll
        for (int j = 0; j < 4; ++j) { const float d = v[i][j] - mean; q += d * d; }
#pragma unroll
      for (int o = 32; o >= 1; o >>= 1) q += __shfl_xor(q, o);
      const float rstd = rsqrtf(q * (1.f / D) + 1e-5f);
#pragma unroll
      for (int i = 0; i < 4; ++i) {
        const f32x4 gg = *(const f32x4*)(g + i * 256 + l * 4);
        const f32x4 bb = *(const f32x4*)(b + i * 256 + l * 4);
#pragma unroll
        for (int j = 0; j < 4; ++j) v[i][j] = (v[i][j] - mean) * rstd * gg[j] + bb[j];
      }
    }
#pragma unroll
    for (int i = 0; i < 4; ++i) *(f32x4*)(X + (size_t)row * D + i * 256 + l * 4) = v[i];
    if (hlayer >= 0) {
      const float* mp = MOD + (size_t)(hlayer * 5 + mod_index(row)) * 6144;
#pragma unroll
      for (int i = 0; i < 4; ++i) {
        const f32x4 sh = *(const f32x4*)(mp + shoff + i * 256 + l * 4);
        const f32x4 sc = *(const f32x4*)(mp + scoff + i * 256 + l * 4);
        u32x2 pv;
        pv[0] = pk2(v[i][0] * (1.f + sc[0]) + sh[0], v[i][1] * (1.f + sc[1]) + sh[1]);
        pv[1] = pk2(v[i][2] * (1.f + sc[2]) + sh[2], v[i][3] * (1.f + sc[3]) + sh[3]);
        *(u32x2*)(H + (size_t)row * D + i * 256 + l * 4) = pv;
      }
    }
  }
}

DI void prep_transpose_tile(const float* __restrict__ src, int K, int N, u16* __restrict__ dst, int tk, int tn, float* tile) {
  const int t = tid_();
  __syncthreads();
#pragma unroll
  for (int i = 0; i < 2; ++i) {
    const int row = (t >> 3) + 32 * i, c4 = (t & 7) * 4;
    const f32x4 v = *(const f32x4*)(src + (size_t)(tk * 64 + row) * N + tn * 32 + c4);
    tile[row * 33 + c4 + 0] = v[0];
    tile[row * 33 + c4 + 1] = v[1];
    tile[row * 33 + c4 + 2] = v[2];
    tile[row * 33 + c4 + 3] = v[3];
  }
  __syncthreads();
  const int n = t >> 3, kc = (t & 7) * 8;
  u32x4 o;
#pragma unroll
  for (int i = 0; i < 4; ++i) o[i] = pk2(tile[(kc + 2 * i) * 33 + n], tile[(kc + 2 * i + 1) * 33 + n]);
  *(u32x4*)(dst + (size_t)(tn * 32 + n) * K + tk * 64 + kc) = o;
}

DI void prep_mod_item(const Params& p, int item, char* lds) {
  float* sv = (float*)lds;
  float* red = sv + 5 * 1024;
  const int t = tid_();
  const int layer = item / 96, c0 = (item % 96) * 64;
  __syncthreads();
  for (int idx = t; idx < 5 * 1024; idx += 256) {
    const int m = idx >> 10, k = idx & 1023;
    const float x = m == 0 ? p.c_ctx[k] : p.c[(m - 1) * 1024 + k];
    sv[idx] = siluf(x);
  }
  __syncthreads();
  const int c4 = t & 15, kg = t >> 4;
  float acc[5][4];
#pragma unroll
  for (int m = 0; m < 5; ++m)
#pragma unroll
    for (int j = 0; j < 4; ++j) acc[m][j] = 0.f;
  const float* wp = p.w_mod + (size_t)layer * 1024 * 6144 + c0 + c4 * 4;
#pragma unroll 4
  for (int k = kg; k < 1024; k += 16) {
    const f32x4 wv = *(const f32x4*)(wp + (size_t)k * 6144);
#pragma unroll
    for (int m = 0; m < 5; ++m) {
      const float s = sv[m * 1024 + k];
#pragma unroll
      for (int j = 0; j < 4; ++j) acc[m][j] += s * wv[j];
    }
  }
#pragma unroll
  for (int m = 0; m < 5; ++m)
#pragma unroll
    for (int j = 0; j < 4; ++j) red[(kg * 5 + m) * 64 + c4 * 4 + j] = acc[m][j];
  __syncthreads();
  float* MOD = (float*)(p.ws + WS_MOD);
  for (int idx = t; idx < 320; idx += 256) {
    const int m = idx >> 6, cc = idx & 63;
    float s = p.b_mod[layer * 6144 + c0 + cc];
    for (int q = 0; q < 16; ++q) s += red[(q * 5 + m) * 64 + cc];
    MOD[(size_t)(layer * 5 + m) * 6144 + c0 + cc] = s;
  }
}

DI void prep_phase(const Params& p, char* lds) {
  const int t = tid_();
  constexpr int N_MOD = 384, N_TR = 24480, N_CK = 640, N_ROPE = 32;
  for (int item = bid_(); item < N_MOD + N_TR + N_CK + N_ROPE; item += gsz_()) {
    if (item < N_MOD) {
      prep_mod_item(p, item, lds);
    } else if (item < N_MOD + N_TR) {
      int i = item - N_MOD;
      const float* src; u16* dst; int K, N, per; size_t sstride, dstride;
      if (i < 3072) { src = p.w_in_even; dst = (u16*)(p.ws + WS_WT_IN_E); K = 1024; N = 3072; per = 1536; sstride = (size_t)1024 * 3072; dstride = sstride; }
      else if (i < 4096) { i -= 3072; src = p.w_out_even; dst = (u16*)(p.ws + WS_WT_OUT_E); K = 1024; N = 1024; per = 512; sstride = (size_t)1024 * 1024; dstride = sstride; }
      else if (i < 6432) { i -= 4096; src = p.w_in_odd; dst = (u16*)(p.ws + WS_WT_IN_O); K = 1024; N = 2336; per = 1168; sstride = (size_t)1024 * 2336; dstride = (size_t)2560 * 1024; }
      else if (i < 7456) { i -= 6432; src = p.w_out_odd; dst = (u16*)(p.ws + WS_WT_OUT_O); K = 1024; N = 1024; per = 512; sstride = (size_t)1024 * 1024; dstride = sstride; }
      else if (i < 15648) { i -= 7456; src = p.w_ff1; dst = (u16*)(p.ws + WS_WT_FF1); K = 1024; N = 4096; per = 2048; sstride = (size_t)1024 * 4096; dstride = sstride; }
      else if (i < 23840) { i -= 15648; src = p.w_ff2; dst = (u16*)(p.ws + WS_WT_FF2); K = 4096; N = 1024; per = 2048; sstride = (size_t)1024 * 4096; dstride = sstride; }
      else if (i < 24352) { i -= 23840; src = p.cache_diff_v; dst = (u16*)(p.ws + WS_CVT_DIFF); K = 256; N = 128; per = 16; sstride = (size_t)256 * 128; dstride = sstride; }
      else { i -= 24352; src = p.cache_swa_v; dst = (u16*)(p.ws + WS_CVT_SWA); K = 256; N = 64; per = 8; sstride = (size_t)256 * 64; dstride = sstride; }
      const int mat = i / per, r = i - mat * per;
      const int ntn = N >> 5;
      const int tk = r / ntn, tn = r - tk * ntn;
      prep_transpose_tile(src + mat * sstride, K, N, dst + mat * dstride, tk, tn, (float*)lds);
    } else if (item < N_MOD + N_TR + N_CK) {
      const int i = item - N_MOD - N_TR;
      const float* src; u16* dst; int j;
      if (i < 512) { src = p.cache_diff_k; dst = (u16*)(p.ws + WS_CK_DIFF); j = i; }
      else { src = p.cache_swa_k; dst = (u16*)(p.ws + WS_CK_SWA); j = i - 512; }
      const size_t off = (size_t)j * 2048 + t * 8;
      const f32x4 a = *(const f32x4*)(src + off), b = *(const f32x4*)(src + off + 4);
      u32x4 o;
      o[0] = pk2(a[0], a[1]); o[1] = pk2(a[2], a[3]); o[2] = pk2(b[0], b[1]); o[3] = pk2(b[2], b[3]);
      *(u32x4*)(dst + off) = o;
    } else {
      const int i = item - N_MOD - N_TR - N_CK;
      f32x2* ROPE = (f32x2*)(p.ws + WS_ROPE);
      for (int q = 0; q < 8; ++q) {
        const int idx = i * 2048 + q * 256 + t;
        const int tp = idx >> 5, j = idx & 31;
        const float fr = powf(10000.f, -(float)(j & 15) * (1.f / 16.f));
        const float ang = (float)(j < 16 ? (tp >> 6) : (tp & 63)) * fr;
        float sn, cs;
        sincosf(ang, &sn, &cs);
        f32x2 o = {cs, sn};
        ROPE[idx] = o;
      }
    }
  }
}


#define XB_TMO      128
#define XB_XCNT(j)  (256  + 64 * (j))
#define XB_XSUB(j)  (1280 + 64 * (j))
#define XB_XGEN(j)  (2304 + 64 * (j))
#define XB_TOP      3328
#define XB_TOPGEN   3392
#define XCD_BAR_WORDS 3456
#define XB_SPIN_CAP (1u << 22)
DI unsigned xb_ld(unsigned* p) { return __hip_atomic_load(p, __ATOMIC_RELAXED, __HIP_MEMORY_SCOPE_AGENT); }
DI unsigned xb_add(unsigned* p, unsigned v) { return __hip_atomic_fetch_add(p, v, __ATOMIC_RELAXED, __HIP_MEMORY_SCOPE_AGENT); }
DI unsigned xb_xcc_id() { return (unsigned)__builtin_amdgcn_s_getreg((3 << 11) | 20) & 0xFu; }
#define XB_SPIN(cond, bar) do { unsigned _sp = 0; while (cond) { __builtin_amdgcn_s_sleep(1); \
    if ((++_sp & 255u) == 0u) { if (xb_ld(&(bar)[XB_TMO])) break; if (_sp > XB_SPIN_CAP) { atomicAdd(&(bar)[XB_TMO], 1u); break; } } } } while (0)
struct XcdBarrier { unsigned* bar; unsigned x; volatile LAS unsigned* st; };
DI XcdBarrier xcd_barrier_post(unsigned* bar, volatile LAS unsigned* st) {
  XcdBarrier b; b.bar = bar; b.x = xb_xcc_id(); b.st = st;
  if (threadIdx.x == 0) (void)xb_add(&bar[XB_XCNT(b.x)], 1u);
  return b;
}
DI void xcd_barrier_complete(unsigned* bar, unsigned x, unsigned& nloc, unsigned& nx) {
  const unsigned G = gridDim.x * gridDim.y * gridDim.z;
  unsigned sum, cnt, mine, sp = 0u;
  for (;;) {
    sum = 0u; cnt = 0u; mine = 0u;
#pragma unroll
    for (unsigned j = 0; j < 16; ++j) { const unsigned c = xb_ld(&bar[XB_XCNT(j)]); sum += c; cnt += (c > 0u) ? 1u : 0u; mine = (j == x) ? c : mine; }
    if (sum == G) break;
    __builtin_amdgcn_s_sleep(1);
    if ((++sp & 255u) == 0u) { if (xb_ld(&bar[XB_TMO])) break; if (sp > XB_SPIN_CAP) { atomicAdd(&bar[XB_TMO], 1u); break; } }
  }
  nloc = mine > 0u ? mine : 1u; nx = cnt > 0u ? cnt : 1u;
}
DI void xcd_barrier(const XcdBarrier& b) {
  asm volatile("s_waitcnt vmcnt(0)" ::: "memory");
  __syncthreads();
  if (threadIdx.x == 0) {
    unsigned* bar = b.bar;
    __builtin_amdgcn_s_waitcnt(0);
    unsigned nloc = b.st[0], nx = b.st[1];
    if (nloc == 0u) { xcd_barrier_complete(bar, b.x, nloc, nx); b.st[0] = nloc; b.st[1] = nx; }
    const unsigned old = xb_add(&bar[XB_XSUB(b.x)], 1u);
    const unsigned gen = old / nloc;
    if (old + 1u == (gen + 1u) * nloc) {
      __builtin_amdgcn_fence(__ATOMIC_RELEASE, "agent");
      asm volatile("s_waitcnt vmcnt(0)" ::: "memory");
      const unsigned og = xb_add(&bar[XB_TOP], 1u);
      const unsigned tg = og / nx;
      if (og + 1u == (tg + 1u) * nx) xb_add(&bar[XB_TOPGEN], 1u);
      else XB_SPIN(xb_ld(&bar[XB_TOPGEN]) == tg, bar);
      __builtin_amdgcn_fence(__ATOMIC_ACQUIRE, "agent");
      xb_add(&bar[XB_XGEN(b.x)], 1u);
      asm volatile("s_waitcnt vmcnt(0)" ::: "memory");
    } else {
      XB_SPIN(xb_ld(&bar[XB_XGEN(b.x)]) == gen, bar);
      __builtin_amdgcn_fence(__ATOMIC_ACQUIRE, "agent");
      asm volatile("s_waitcnt vmcnt(0)" ::: "memory");
    }
  }
  __syncthreads();
}

#ifndef PH_MASK
#define PH_MASK 0xfff
#endif
DI void run_phase(const Params& p0, int ph, char* lds0) {
  Params p = p0;
  asm volatile("" : "+s"(p.ws), "+s"(p.out));
  char* lds = lds0;
  char* vl = lds0 + vb_() * 49152;
  if (ph == 0) { if (PH_MASK & 0x200) prep_phase(p, vl); return; }
  if (ph == 1) { if (PH_MASK & 0x400) ln_phase(p, 1, nullptr, nullptr, 0, 0, 1024); return; }
  const int layer = (ph - 2) / 9, sub = (ph - 2) % 9;
  const bool even = (layer & 1) == 0;
  const int eo = layer >> 1;
  const u16* H = (const u16*)(p.ws + WS_H);
  if (!((PH_MASK >> sub) & 1)) return;
  switch (sub) {
    case 0:
      if (even) gemm_phase<EPI_PROJ>(p, layer, H, (const u16*)(p.ws + WS_WT_IN_E) + (size_t)eo * 3072 * 1024, 1024, 12, 0, lds);
      else gemm_phase<EPI_PROJ>(p, layer, H, (const u16*)(p.ws + WS_WT_IN_O) + (size_t)eo * 2560 * 1024, 1024, 10, 0, lds);
      break;
    case 1: mix_phase(p, layer, vl); break;
    case 2:
      for (int item = bid_(); item < 5120; item += gsz_()) lin_scan_item(p, layer, item);
      break;
    case 3:
      for (int item = bid_(); item < 768; item += gsz_()) lin_g3_item(p, layer, item, vl);
      break;
    case 4:
      gemm_phase<EPI_RESID>(p, layer, H, (const u16*)(p.ws + (even ? WS_WT_OUT_E : WS_WT_OUT_O)) + (size_t)eo * 1024 * 1024, 1024, 4, 2048, lds);
      break;
    case 5: ln_phase(p, 0, p.ln_g + (layer * 2) * 1024, p.ln_b + (layer * 2) * 1024, layer, 3072, 4096); break;
    case 6:
      gemm_phase<EPI_RELU2>(p, layer, H, (const u16*)(p.ws + WS_WT_FF1) + (size_t)layer * 4096 * 1024, 1024, 16, 0, lds);
      break;
    case 7:
      gemm_phase<EPI_RESID>(p, layer, (const u16*)(p.ws + WS_FFH), (const u16*)(p.ws + WS_WT_FF2) + (size_t)layer * 4096 * 1024, 4096, 4, 5120, lds);
      break;
    case 8: ln_phase(p, 0, p.ln_g + (layer * 2 + 1) * 1024, p.ln_b + (layer * 2 + 1) * 1024, layer < 3 ? layer + 1 : -1, 0, 1024); break;
  }
}

__global__ void __launch_bounds__(512) mega_kernel(Params p) {
  __shared__ __attribute__((aligned(16))) char lds[131072];
  __shared__ uint4 xb_words;
  cg::grid_group grid = cg::this_grid();
  if (threadIdx.x == 0) xb_words = make_uint4(0u, 0u, 0u, 0u);
  __syncthreads();
  XcdBarrier bar = xcd_barrier_post((unsigned*)(p.ws + WS_BAR), (volatile LAS unsigned*)&xb_words);
  for (int ph = p.ph_lo; ph < p.ph_hi; ++ph) {
    run_phase(p, ph, lds);
    if (ph + 1 < p.ph_hi) {
      if (p.ph_lo < 0) grid.sync();
      xcd_barrier(bar);
    }
  }
}

extern "C" void kernel_launch(void* const* d_in, const int* in_sizes, int n_in, void* d_out, int out_size, void* d_ws, size_t ws_size,
                              hipStream_t stream) {
  static int grid_blocks = 0;
  if (!grid_blocks) {
    int dev = 0, cus = 0, per_cu = 0;
    hipGetDevice(&dev);
    hipDeviceGetAttribute(&cus, hipDeviceAttributeMultiprocessorCount, dev);
    hipOccupancyMaxActiveBlocksPerMultiprocessor(&per_cu, mega_kernel, 512, 0);
    if (per_cu < 1) per_cu = 1;
    if (per_cu > 1) per_cu = 1;
    grid_blocks = cus * per_cu;
    if (ws_size < WS_END) fprintf(stderr, "kernel_launch: workspace too small: %zu < %zu\n", ws_size, (size_t)WS_END);
  }
  Params p{};
  const float** pp = (const float**)&p;
  for (int i = 0; i < 25; ++i) pp[i] = (const float*)d_in[i];
  p.out = (float*)d_out;
  p.ws = (char*)d_ws;
#if ONE_LAUNCH
  (void)hipMemsetAsync((char*)d_ws + WS_BAR, 0, 16384, stream);
  p.ph_lo = 0;
  p.ph_hi = NPH;
  void* args[] = {&p};
  hipError_t e = hipLaunchCooperativeKernel((void*)mega_kernel, dim3(grid_blocks), dim3(512), args, 0, stream);
  if (e != hipSuccess) fprintf(stderr, "cooperative launch failed: %s (grid %d)\n", hipGetErrorString(e), grid_blocks);
#else
  for (int ph = 0; ph < NPH; ++ph) {
    p.ph_lo = ph;
    p.ph_hi = ph + 1;
    hipLaunchKernelGGL(mega_kernel, dim3(grid_blocks), dim3(512), 0, stream, p);
  }
#endif
}
```
